# Optimizing an MI355X kernel written in HIP

```python
import math
import jax, jax.numpy as jnp
from jax import lax
import numpy as np

D_MODEL = 1024
BATCH = 2
SEQ = 8192
DEPTH = 2
DEC_BATCH = 8
DEC_SEQ = 8192
PAST_LEN = 128

N_META = 16
BLOCK = 128
META_START = BLOCK - N_META
D_MIX = D_MODEL
A_HEADS = 4
A_QK_DIM = 64
A_V_DIM = 2 * A_QK_DIM
B_HEADS = 4
B_KV_HEADS = 2
B_HEAD_DIM = 64
WINDOW = 128
C_HEADS = 4
C_Q_RANK = 256
C_KV_RANK = 128
C_NOPE_DIM = 64
C_ROPE_DIM = 32
C_V_DIM = 64
ROPE_THETA = 10000.0
N_BUCKETS = 32
MAX_DISTANCE = 128
N_BIAS_HEADS = A_HEADS + B_HEADS
D_FF = 2816
EPS = 1e-6

IN_SIZES = (A_HEADS * 2 * A_QK_DIM, A_HEADS * 2 * A_QK_DIM, A_HEADS * A_V_DIM,
            B_HEADS * B_HEAD_DIM, B_KV_HEADS * B_HEAD_DIM, B_KV_HEADS * B_HEAD_DIM,
            C_Q_RANK, C_KV_RANK, C_ROPE_DIM)
D_IN = sum(IN_SIZES)
SPLIT_POINTS = tuple(sum(IN_SIZES[:i + 1]) for i in range(len(IN_SIZES) - 1))

kernel_name = "hymba_style_diff_window_mla_encoder"


def rmsnorm(x, g):
    xf = x.astype(jnp.float32)
    y = xf * lax.rsqrt(jnp.mean(xf * xf, axis=-1, keepdims=True) + EPS)
    return (y * g.astype(jnp.float32)).astype(x.dtype)


def swiglu(x, w_gu, w_down):
    g, u = jnp.split(x @ w_gu, 2, axis=-1)
    return (jax.nn.silu(g) * u) @ w_down


def t5_bucket(rel):
    half = N_BUCKETS // 2
    max_exact = half // 2
    ret = jnp.where(rel > 0, half, 0)
    n = jnp.abs(rel)
    nf = jnp.maximum(n, 1).astype(jnp.float32)
    large = max_exact + (jnp.log(nf / max_exact) / math.log(MAX_DISTANCE / max_exact)
                         * (half - max_exact)).astype(jnp.int32)
    large = jnp.minimum(large, half - 1)
    return ret + jnp.where(n < max_exact, n, large)


def rope_tables(pos):
    inv = ROPE_THETA ** (-jnp.arange(0, C_ROPE_DIM, 2, dtype=jnp.float32) / C_ROPE_DIM)
    ang = pos[:, None] * inv[None, :]
    ang = jnp.concatenate([ang, ang], axis=-1)
    return jnp.cos(ang), jnp.sin(ang)


def apply_rope(x, cos, sin):
    x1, x2 = jnp.split(x, 2, axis=-1)
    rot = jnp.concatenate([-x2, x1], axis=-1)
    return (x.astype(jnp.float32) * cos + rot.astype(jnp.float32) * sin).astype(x.dtype)


def diff_attention(q, k, v, lam, bias_tab, key_ok, slot):
    B, Lp = q.shape[0], q.shape[1]
    nb = Lp // BLOCK
    qb = jnp.moveaxis(q.reshape(B, nb, BLOCK, A_HEADS, 2, A_QK_DIM), 1, 0)
    scale = A_QK_DIM ** -0.5

    def one_block(args):
        qi, start = args
        s = jnp.einsum('bqhmd,bkhmd->bhmqk', qi, k).astype(jnp.float32) * scale
        qslot = start + jnp.arange(BLOCK)
        bias = bias_tab[t5_bucket(slot[None, :] - qslot[:, None])].astype(jnp.float32)
        s = s + jnp.transpose(bias, (2, 0, 1))[None, :, None]
        s = jnp.where(key_ok, s, -jnp.inf)
        p = jax.nn.softmax(s, axis=-1)
        w = p[:, :, 0] - lam * p[:, :, 1]
        return jnp.einsum('bhqk,bkhe->bqhe', w.astype(v.dtype), v)

    o = lax.map(one_block, (qb, jnp.arange(nb) * BLOCK))
    return jnp.moveaxis(o, 0, 1).reshape(B, Lp, A_HEADS, A_V_DIM)


def window_gqa(q, k, v, sinks, bias_tab):
    B, Lp = q.shape[0], q.shape[1]
    nb = Lp // BLOCK
    G = B_HEADS // B_KV_HEADS
    qb = q.reshape(B, nb, BLOCK, B_KV_HEADS, G, B_HEAD_DIM)

    def neighbours(t):
        tb = t.reshape(B, nb, BLOCK, B_KV_HEADS, B_HEAD_DIM)
        tp = jnp.pad(tb, ((0, 0), (1, 1), (0, 0), (0, 0), (0, 0)))
        return jnp.concatenate([tp[:, :-2], tp[:, 1:-1], tp[:, 2:]], axis=2)

    kn, vn = neighbours(k), neighbours(v)
    s = jnp.einsum('bnqhgd,bnkhd->bnhgqk', qb, kn).astype(jnp.float32) * B_HEAD_DIM ** -0.5
    rel = (jnp.arange(3 * BLOCK) - BLOCK)[None, :] - jnp.arange(BLOCK)[:, None]
    bias = bias_tab[t5_bucket(rel)].astype(jnp.float32).reshape(BLOCK, 3 * BLOCK, B_KV_HEADS, G)
    s = s + jnp.transpose(bias, (2, 3, 0, 1))[None, None]
    kslot = (jnp.arange(nb)[:, None] - 1) * BLOCK + jnp.arange(3 * BLOCK)[None, :]
    ok = (jnp.abs(rel) <= WINDOW)[None] & ((kslot >= META_START) & (kslot < Lp))[:, None, :]
    s = jnp.where(ok[None, :, None, None], s, -jnp.inf)
    sink = jnp.broadcast_to(sinks.astype(jnp.float32).reshape(B_KV_HEADS, G, 1, 1), s.shape[:-1] + (1,))
    p = jax.nn.softmax(jnp.concatenate([s, sink], axis=-1), axis=-1)[..., :-1]
    o = jnp.einsum('bnhgqk,bnkhd->bnqhgd', p.astype(v.dtype), vn)
    return o.reshape(B, Lp, B_HEADS * B_HEAD_DIM)


def mla(cq, ckv, kr, g_cq, g_ckv, w_uq, w_ukv, cos, sin, key_ok):
    B, Lp = cq.shape[0], cq.shape[1]
    nb = Lp // BLOCK
    q = (rmsnorm(cq, g_cq) @ w_uq).reshape(B, Lp, C_HEADS, C_NOPE_DIM + C_ROPE_DIM)
    q = jnp.concatenate([q[..., :C_NOPE_DIM],
                         apply_rope(q[..., C_NOPE_DIM:], cos[:, None], sin[:, None])], axis=-1)
    kv = (rmsnorm(ckv, g_ckv) @ w_ukv).reshape(B, Lp, C_HEADS, C_NOPE_DIM + C_V_DIM)
    k_nope, v = kv[..., :C_NOPE_DIM], kv[..., C_NOPE_DIM:]
    k_rope = apply_rope(kr, cos, sin)
    k = jnp.concatenate([k_nope, jnp.broadcast_to(k_rope[:, :, None], (B, Lp, C_HEADS, C_ROPE_DIM))], axis=-1)
    scale = (C_NOPE_DIM + C_ROPE_DIM) ** -0.5
    qb = jnp.moveaxis(q.reshape(B, nb, BLOCK, C_HEADS, C_NOPE_DIM + C_ROPE_DIM), 1, 0)

    def one_block(qi):
        s = jnp.einsum('bqhd,bkhd->bhqk', qi, k).astype(jnp.float32) * scale
        s = jnp.where(key_ok, s, -jnp.inf)
        p = jax.nn.softmax(s, axis=-1)
        return jnp.einsum('bhqk,bkhd->bqhd', p.astype(v.dtype), v)

    o = lax.map(one_block, qb)
    return jnp.moveaxis(o, 0, 1).reshape(B, Lp, C_HEADS * C_V_DIM)


def trunk(x, meta, rel_bias, g_ffn1, w_ffn1_gu, w_ffn1_down, g_mix, w_in, diff_lambda, g_subln,
          sinks, g_cq, g_ckv, w_uq, w_ukv, w_out, g_ffn2, w_ffn2_gu, w_ffn2_down, g_final):
    B, S, D = x.shape
    Lp = BLOCK + S
    lead = jnp.concatenate([jnp.zeros((META_START, D), x.dtype), meta.astype(x.dtype)], axis=0)
    h = jnp.concatenate([jnp.broadcast_to(lead[None], (B, BLOCK, D)), x], axis=1)
    slot = jnp.arange(Lp)
    key_ok = slot >= META_START
    cos, sin = rope_tables((slot - META_START).astype(jnp.float32))
    for l in range(DEPTH):
        h = h + 0.5 * swiglu(rmsnorm(h, g_ffn1[l]), w_ffn1_gu[l], w_ffn1_down[l])
        u = rmsnorm(h, g_mix[l]) @ w_in[l]
        aq, ak, av, bq, bk, bv, cq, ckv, kr = jnp.split(u, SPLIT_POINTS, axis=-1)
        lam_init = 0.8 - 0.6 * math.exp(-0.3 * l)
        dl = diff_lambda[l].astype(jnp.float32)
        lam = jnp.exp(jnp.sum(dl[0] * dl[1])) - jnp.exp(jnp.sum(dl[2] * dl[3])) + lam_init
        oa = diff_attention(aq.reshape(B, Lp, A_HEADS, 2, A_QK_DIM), ak.reshape(B, Lp, A_HEADS, 2, A_QK_DIM),
                            av.reshape(B, Lp, A_HEADS, A_V_DIM), lam, rel_bias[:, :A_HEADS], key_ok, slot)
        oa = (rmsnorm(oa, g_subln[l]) * (1.0 - lam_init)).reshape(B, Lp, A_HEADS * A_V_DIM)
        ob = window_gqa(bq.reshape(B, Lp, B_HEADS, B_HEAD_DIM), bk.reshape(B, Lp, B_KV_HEADS, B_HEAD_DIM),
                        bv.reshape(B, Lp, B_KV_HEADS, B_HEAD_DIM), sinks[l], rel_bias[:, A_HEADS:])
        oc = mla(cq, ckv, kr, g_cq[l], g_ckv[l], w_uq[l], w_ukv[l], cos, sin, key_ok)
        h = h + jnp.concatenate([oa, ob, oc], axis=-1) @ w_out[l]
        h = h + 0.5 * swiglu(rmsnorm(h, g_ffn2[l]), w_ffn2_gu[l], w_ffn2_down[l])
    return rmsnorm(h[:, BLOCK:], g_final)


def setup_inputs(seed: int = 0) -> dict:
    key = jax.random.key(seed)
    ks = jax.random.split(key, 24)

    def nrm(k, shape, scale):
        return jax.random.normal(k, shape, jnp.float32) * scale

    def gain(k, shape):
        return 1.0 + 0.05 * jax.random.normal(k, shape, jnp.float32)

    return {
        "x_prompt": nrm(ks[0], (BATCH, SEQ, D_MODEL), 1.0),
        "x_sample": nrm(ks[1], (DEC_BATCH, DEC_SEQ, D_MODEL), 1.0),
        "meta": nrm(ks[2], (N_META, D_MODEL), 1.0),
        "rel_bias": nrm(ks[3], (N_BUCKETS, N_BIAS_HEADS), 0.5),
        "g_ffn1": gain(ks[4], (DEPTH, D_MODEL)),
        "w_ffn1_gu": nrm(ks[5], (DEPTH, D_MODEL, 2 * D_FF), D_MODEL ** -0.5),
        "w_ffn1_down": nrm(ks[6], (DEPTH, D_FF, D_MODEL), D_FF ** -0.5),
        "g_mix": gain(ks[7], (DEPTH, D_MODEL)),
        "w_in": nrm(ks[8], (DEPTH, D_MODEL, D_IN), D_MODEL ** -0.5),
        "diff_lambda": nrm(ks[9], (DEPTH, 4, A_QK_DIM), 0.1),
        "g_subln": gain(ks[10], (DEPTH, A_V_DIM)),
        "sinks": nrm(ks[11], (DEPTH, B_HEADS), 0.5),
        "g_cq": gain(ks[12], (DEPTH, C_Q_RANK)),
        "g_ckv": gain(ks[13], (DEPTH, C_KV_RANK)),
        "w_uq": nrm(ks[14], (DEPTH, C_Q_RANK, C_HEADS * (C_NOPE_DIM + C_ROPE_DIM)), C_Q_RANK ** -0.5),
        "w_ukv": nrm(ks[15], (DEPTH, C_KV_RANK, C_HEADS * (C_NOPE_DIM + C_V_DIM)), C_KV_RANK ** -0.5),
        "w_out": nrm(ks[16], (DEPTH, D_MIX, D_MODEL), D_MIX ** -0.5),
        "g_ffn2": gain(ks[17], (DEPTH, D_MODEL)),
        "w_ffn2_gu": nrm(ks[18], (DEPTH, D_MODEL, 2 * D_FF), D_MODEL ** -0.5),
        "w_ffn2_down": nrm(ks[19], (DEPTH, D_FF, D_MODEL), D_FF ** -0.5),
        "g_final": gain(ks[20], (D_MODEL,)),
    }


def reference(x_prompt, x_sample, meta, rel_bias, g_ffn1, w_ffn1_gu, w_ffn1_down, g_mix, w_in,
              diff_lambda, g_subln, sinks, g_cq, g_ckv, w_uq, w_ukv, w_out, g_ffn2, w_ffn2_gu,
              w_ffn2_down, g_final):
    y_prompt = trunk(x_prompt, meta, rel_bias, g_ffn1, w_ffn1_gu, w_ffn1_down, g_mix, w_in, diff_lambda,
                     g_subln, sinks, g_cq, g_ckv, w_uq, w_ukv, w_out, g_ffn2, w_ffn2_gu, w_ffn2_down, g_final)
    y_sample = trunk(x_sample, meta, rel_bias, g_ffn1, w_ffn1_gu, w_ffn1_down, g_mix, w_in, diff_lambda,
                     g_subln, sinks, g_cq, g_ckv, w_uq, w_ukv, w_out, g_ffn2, w_ffn2_gu, w_ffn2_down, g_final)
    return (y_prompt, y_sample)
```

```cpp
#include <hip/hip_runtime.h>
#include <hip/hip_cooperative_groups.h>
#include <cstdio>
#include <cstdint>
namespace cg = cooperative_groups;
#define LAS __attribute__((address_space(3)))
#define GAS __attribute__((address_space(1)))
typedef unsigned short bf16_t;
typedef short bf16x8 __attribute__((ext_vector_type(8)));
typedef float f32x4 __attribute__((ext_vector_type(4)));
typedef float f32x16 __attribute__((ext_vector_type(16)));
typedef unsigned u32x4 __attribute__((ext_vector_type(4)));
typedef unsigned u32x2 __attribute__((ext_vector_type(2)));
typedef short v4i16_t __attribute__((ext_vector_type(4)));

constexpr int NSEQ = 10, LP = 8320, SEQ = 8192, DM = 1024, DFF = 2816, DIN = 2464, DINP = 2560;
constexpr int MROWS = NSEQ * LP;
constexpr int NTHR = 512, NWAVES = 8;
constexpr float LOG2E = 1.4426950408889634f;
constexpr float NEGBIG = -1.0e30f;
constexpr float EPSN = 1e-6f;

constexpr size_t MiB = 1u << 20;
constexpr size_t W_GU1 = 0, W_D1 = W_GU1 + (size_t)5632 * 1024 * 2, W_IN = W_D1 + (size_t)1024 * 2816 * 2, W_UQ = W_IN + (size_t)DINP * 1024 * 2,
                 W_UKV = W_UQ + (size_t)512 * 256 * 2, W_OUT = W_UKV + (size_t)512 * 128 * 2, W_GU2 = W_OUT + (size_t)1024 * 1024 * 2,
                 W_D2 = W_GU2 + (size_t)5632 * 1024 * 2, W_LAYER = W_D2 + (size_t)1024 * 2816 * 2;
static_assert(W_LAYER == 42336256, "weights per layer");
constexpr size_t WS_W = 1 * MiB, WS_LEAD = 82 * MiB, WS_ROPE = 87 * MiB, WS_XN = 89 * MiB, WS_BIG = 252 * MiB;
static_assert(WS_W + 2 * W_LAYER <= WS_LEAD, "ws map");
constexpr size_t WS_SS = 88 * MiB + 256 * 1024;
static_assert(WS_ROPE + (size_t)LP * 32 * 4 <= WS_SS && WS_SS + 2 * (size_t)MROWS * 4 <= WS_XN, "ss map");
constexpr size_t XQ_OFF = 0, XKV_OFF = (size_t)MROWS * 256 * 2;
constexpr size_t U_OFF = 0, KC_OFF = 392 * MiB, VC_OFF = (392 + 61) * MiB, BIG_END = 494 * MiB;
static_assert((size_t)MROWS * DIN * 2 <= KC_OFF && KC_OFF + (size_t)MROWS * 384 * 2 <= VC_OFF && VC_OFF + (size_t)MROWS * 256 * 2 <= BIG_END, "big map");
static_assert((size_t)MROWS * DFF * 2 <= BIG_END && WS_XN + (size_t)MROWS * DM * 2 <= WS_BIG, "big map 2");
constexpr size_t WS_O = WS_BIG + BIG_END;
constexpr size_t WS_END = WS_O + (size_t)MROWS * DM * 2;
static_assert(WS_END <= (size_t)1024 * MiB, "ws budget");

constexpr int LDS_BYTES = 147456;

__device__ __forceinline__ float lane_xor(float v, int lane, int o) { return __builtin_bit_cast(float, __builtin_amdgcn_ds_bpermute((lane ^ o) << 2, __builtin_bit_cast(int, v))); }
__device__ __forceinline__ float wave_sum(float v, int lane) {
#pragma unroll
    for (int o = 1; o < 64; o <<= 1) v += lane_xor(v, lane, o);
    return v;
}
__device__ __forceinline__ unsigned f2bf(float f) { unsigned u = __builtin_bit_cast(unsigned, f); return (u + 0x7fffu + ((u >> 16) & 1u)) >> 16; }
__device__ __forceinline__ unsigned pk2(float lo, float hi) { return f2bf(lo) | (f2bf(hi) << 16); }
__device__ __forceinline__ float bf2f(unsigned short b) { return __builtin_bit_cast(float, (unsigned)b << 16); }

struct Args { const float* in[21]; float* out; unsigned char* ws; };

__device__ __forceinline__ float* hrow(float* LEAD, float* OUT, int r) {
    const int b = r / LP, s = r - b * LP;
    return s < 128 ? LEAD + ((size_t)(b * 128 + s)) * DM : OUT + ((size_t)b * SEQ + (s - 128)) * DM;
}
namespace pg8 {
#define PG8_LAS __attribute__((address_space(3)))
typedef unsigned short bf16_t;
typedef short bf16x8 __attribute__((ext_vector_type(8)));
typedef float f32x4 __attribute__((ext_vector_type(4)));
typedef unsigned u32x4 __attribute__((ext_vector_type(4)));
constexpr int BM = 256, BK = 64, HALF = 128, HTB = HALF * BK * 2  , STAGE_BYTES = 8 * HTB, NXCD = 8, WGM = 8;

__host__ __device__ __forceinline__ int lds_byte(int r, int c) { const int st = (r >> 4) * 2 + (c >> 5), rr = r & 15, cc = c & 31, ob = rr * 64 + cc * 2; return st * 1024 + (ob ^ (((ob >> 9) & 1) << 5)); }
__host__ __device__ __forceinline__ void stage_rc(int b, int& R, int& C) { const int st = b / 1024, sb = b % 1024, swz = sb ^ (((sb >> 9) & 1) << 5); R = (st >> 1) * 16 + swz / 64; C = (st & 1) * 32 + (swz % 64) / 2; }
__host__ __device__ __forceinline__ int perm32(int rho) { const int n = rho >> 4, i = rho & 15; return 8 * (i >> 2) + 4 * n + (i & 3); }

struct Unit { int pm, pn; };
struct Gemm { const bf16_t* A; const bf16_t* Bt; int M, N, K; };

struct StaticOrder {
    int nM, nN, nwg, G, c;
    __host__ __device__ void init(int M, int N, int G_, int c_) { nM = M / BM; nN = N / BM; nwg = nM * nN; G = G_; c = c_; }
    __host__ __device__ bool next(int i, Unit& u) const {
        const long L = (long)i * G + c; if (L >= nwg) return false;
        int wgid = (int)L; { const int q = nwg / NXCD, r = nwg % NXCD, xcd = wgid % NXCD, off = wgid / NXCD; wgid = (xcd < r ? xcd * (q + 1) : r * (q + 1) + (xcd - r) * q) + off; }
        const int nig = WGM * nN, gid = wgid / nig, fm = gid * WGM, gsz = (nM - fm) < WGM ? (nM - fm) : WGM;
        u.pm = fm + ((wgid % nig) % gsz); u.pn = (wgid % nig) / gsz; return true;
    }
    __device__ __forceinline__ void a_ready(const Unit&) const {}
    __device__ __forceinline__ void done(const Unit&) const {}
};

__device__ __forceinline__ unsigned cvt_pk_bf16(float lo, float hi) { unsigned r; asm volatile("v_cvt_pk_bf16_f32 %0, %1, %2" : "=v"(r) : "v"(lo), "v"(hi)); return r; }
typedef float f32x2 __attribute__((ext_vector_type(2)));
__device__ __forceinline__ float silu_mul(float g, float u) { return g * __builtin_amdgcn_rcpf(1.0f + __builtin_amdgcn_exp2f(-g * 1.4426950408889634f)) * u; }
__device__ __forceinline__ f32x2 silu_mul2(f32x2 g, f32x2 u, float kneg, float rs2) {
    const f32x2 t = g * kneg;
    f32x2 e; e.x = __builtin_amdgcn_exp2f(t.x); e.y = __builtin_amdgcn_exp2f(t.y);
    const f32x2 d = e + 1.0f;
    f32x2 r; r.x = __builtin_amdgcn_rcpf(d.x); r.y = __builtin_amdgcn_rcpf(d.y);
    return (g * u) * (r * rs2);
}
struct EpiSwiGLU {
    static constexpr bool PERM = true, AFTER_DRAIN = false;
    bf16_t* O; int ldo; const float* SS;
    __device__ __forceinline__ void operator()(const f32x4 (&acc)[2][2][4][2], const Unit& u, int wr, int wc, int fr_in, int fq_in) const {
        int t_ = threadIdx.x; asm volatile("" : "+v"(t_)); const int fr = t_ & 15, fq = (t_ >> 4) & 3;
        const int row0 = u.pm * BM + wr * 64 + fr, col0 = u.pn * 128 + wc * 32 + 8 * fq;
        float ssv[2][4];
#pragma unroll
        for (int ai = 0; ai < 2; ++ai)
#pragma unroll
            for (int m = 0; m < 4; ++m) ssv[ai][m] = SS[row0 + ai * HALF + m * 16];
#pragma unroll
        for (int ai = 0; ai < 2; ++ai)
#pragma unroll
            for (int m = 0; m < 4; ++m) {
                const int row = row0 + ai * HALF + m * 16;
                const float rs = __builtin_amdgcn_rsqf(ssv[ai][m] * (1.0f / 1024.0f) + 1e-6f);
                const float kneg = -1.4426950408889634f * rs, rs2 = rs * rs;
                bf16_t* rowp = O + (size_t)row * ldo + col0;
                const f32x4 g0 = acc[ai][0][m][0], g1 = acc[ai][0][m][1], u0 = acc[ai][1][m][0], u1 = acc[ai][1][m][1];
                const f32x2 a0 = silu_mul2((f32x2){g0[0], g0[1]}, (f32x2){u0[0], u0[1]}, kneg, rs2), a1 = silu_mul2((f32x2){g0[2], g0[3]}, (f32x2){u0[2], u0[3]}, kneg, rs2);
                const f32x2 a2 = silu_mul2((f32x2){g1[0], g1[1]}, (f32x2){u1[0], u1[1]}, kneg, rs2), a3 = silu_mul2((f32x2){g1[2], g1[3]}, (f32x2){u1[2], u1[3]}, kneg, rs2);
                u32x4 w; w.x = cvt_pk_bf16(a0.x, a0.y); w.y = cvt_pk_bf16(a1.x, a1.y); w.z = cvt_pk_bf16(a2.x, a2.y); w.w = cvt_pk_bf16(a3.x, a3.y);
                *(u32x4*)rowp = w;
            }
    }
};
struct EpiResid {
    static constexpr bool PERM = true, AFTER_DRAIN = false;
    float* LEAD; float* OUT; float alpha; bf16_t* XN; const float* gain; float* SSout;
    const float* XP; const float* XS;
    __device__ __forceinline__ void operator()(const f32x4 (&acc)[2][2][4][2], const Unit& u, int wr, int wc, int fr_in, int fq_in) const {
        int t_ = threadIdx.x; asm volatile("" : "+v"(t_)); const int fr = t_ & 15, fq = (t_ >> 4) & 3, lane = t_ & 63;
        const int row0 = u.pm * BM + wr * 64 + fr, col0 = u.pn * BM + wc * 32 + 8 * fq;
        f32x4 gv[2][2];
#pragma unroll
        for (int bj = 0; bj < 2; ++bj) { gv[bj][0] = *(const f32x4*)(gain + col0 + bj * HALF); gv[bj][1] = *(const f32x4*)(gain + col0 + bj * HALF + 4); }
#pragma unroll
        for (int ai = 0; ai < 2; ++ai) {
            float* hp[4]; f32x4 hv[4][2][2];
#pragma unroll
            for (int m = 0; m < 4; ++m) { const int rw = row0 + ai * HALF + m * 16; hp[m] = hrow(LEAD, OUT, rw) + col0;
                const float* sp = hp[m];
                if (XP) { const int b = rw / LP, sl = rw - b * LP; if (sl >= 128) sp = (b < 2 ? XP + ((size_t)b * SEQ + (sl - 128)) * DM : XS + ((size_t)(b - 2) * SEQ + (sl - 128)) * DM) + col0; }
#pragma unroll
                for (int bj = 0; bj < 2; ++bj) { hv[m][bj][0] = *(const f32x4*)(sp + bj * HALF); hv[m][bj][1] = *(const f32x4*)(sp + bj * HALF + 4); } }
#pragma unroll
            for (int m = 0; m < 4; ++m) {
                const int row = row0 + ai * HALF + m * 16;
                bf16_t* xp = XN + (size_t)row * DM + col0;
                float sq = 0.f;
#pragma unroll
                for (int bj = 0; bj < 2; ++bj) {
                    const f32x4 a = hv[m][bj][0] + acc[ai][bj][m][0] * alpha, b = hv[m][bj][1] + acc[ai][bj][m][1] * alpha;
                    *(f32x4*)(hp[m] + bj * HALF) = a; *(f32x4*)(hp[m] + bj * HALF + 4) = b;
                    sq += (a[0] * a[0] + a[1] * a[1]) + (a[2] * a[2] + a[3] * a[3]) + (b[0] * b[0] + b[1] * b[1]) + (b[2] * b[2] + b[3] * b[3]);
                    const f32x4 xa = a * gv[bj][0], xb = b * gv[bj][1];
                    u32x4 w; w.x = cvt_pk_bf16(xa[0], xa[1]); w.y = cvt_pk_bf16(xa[2], xa[3]); w.z = cvt_pk_bf16(xb[0], xb[1]); w.w = cvt_pk_bf16(xb[2], xb[3]);
                    *(u32x4*)(xp + bj * HALF) = w;
                }
                sq += lane_xor(sq, lane, 16); sq += lane_xor(sq, lane, 32);
                if (fq == 0) atomicAdd(SSout + row, sq);
            }
        }
    }
};
struct EpiU {
    static constexpr bool PERM = true, AFTER_DRAIN = false;
    bf16_t* U; float qs; const float* SS;
    __device__ __forceinline__ void operator()(const f32x4 (&acc)[2][2][4][2], const Unit& u, int wr, int wc, int fr_in, int fq_in) const {
        int t_ = threadIdx.x; asm volatile("" : "+v"(t_)); const int fr = t_ & 15, fq = (t_ >> 4) & 3;
        const int row0 = u.pm * BM + wr * 64 + fr, col0 = u.pn * BM + wc * 32 + 8 * fq;
        const float sc = (u.pn < 2 || u.pn == 6) ? qs : 1.0f;
        float ssv[2][4];
#pragma unroll
        for (int ai = 0; ai < 2; ++ai)
#pragma unroll
            for (int m = 0; m < 4; ++m) ssv[ai][m] = SS[row0 + ai * HALF + m * 16];
#pragma unroll
        for (int ai = 0; ai < 2; ++ai)
#pragma unroll
            for (int m = 0; m < 4; ++m) {
                const int row = row0 + ai * HALF + m * 16;
                const float rs = __builtin_amdgcn_rsqf(ssv[ai][m] * (1.0f / 1024.0f) + 1e-6f) * sc;
                bf16_t* rowp = U + (size_t)row * DIN + col0;
#pragma unroll
                for (int bj = 0; bj < 2; ++bj) {
                    if (col0 + bj * HALF < DIN) {
                        const f32x4 v0 = acc[ai][bj][m][0] * rs, v1 = acc[ai][bj][m][1] * rs;
                        u32x4 w; w.x = cvt_pk_bf16(v0[0], v0[1]); w.y = cvt_pk_bf16(v0[2], v0[3]); w.z = cvt_pk_bf16(v1[0], v1[1]); w.w = cvt_pk_bf16(v1[2], v1[3]);
                        *(u32x4*)(rowp + bj * HALF) = w;
                    }
                }
            }
    }
};
struct EpiQC {
    static constexpr bool PERM = false, AFTER_DRAIN = false;
    bf16_t* U; const float* rope; float qs;
    __device__ __forceinline__ void operator()(const f32x4 (&acc)[2][2][4][2], const Unit& u, int wr, int wc, int fr_in, int fq_in) const {
        int t_ = threadIdx.x; asm volatile("" : "+v"(t_)); const int fr = t_ & 15, fq = (t_ >> 4) & 3;
        const int row0 = u.pm * BM + wr * 64 + fr;
#pragma unroll
        for (int bj = 0; bj < 2; ++bj) {
            const int cg0 = u.pn * BM + bj * HALF + wc * 32;
            if (cg0 >= 384) continue;
            const bool isrope = ((cg0 >> 5) % 3) == 2;
#pragma unroll
            for (int ai = 0; ai < 2; ++ai)
#pragma unroll
                for (int m = 0; m < 4; ++m) {
                    const int r = row0 + ai * HALF + m * 16;
                    f32x4 x1 = acc[ai][bj][m][0] * qs, x2 = acc[ai][bj][m][1] * qs;
                    if (isrope) {
                        const int s = r % LP;
                        const f32x4 cs = *(const f32x4*)(rope + (size_t)s * 32 + 4 * fq), sn = *(const f32x4*)(rope + (size_t)s * 32 + 16 + 4 * fq);
                        const f32x4 o1 = x1 * cs - x2 * sn, o2 = x2 * cs + x1 * sn; x1 = o1; x2 = o2;
                    }
                    bf16_t* p = U + (size_t)r * DIN + 2048 + cg0 + 4 * fq;
                    u32x2 w1, w2; w1.x = cvt_pk_bf16(x1[0], x1[1]); w1.y = cvt_pk_bf16(x1[2], x1[3]); w2.x = cvt_pk_bf16(x2[0], x2[1]); w2.y = cvt_pk_bf16(x2[2], x2[3]);
                    *(u32x2*)p = w1; *(u32x2*)(p + 16) = w2;
                }
        }
    }
};
struct EpiKV {
    static constexpr bool PERM = true, AFTER_DRAIN = false;
    bf16_t* KC; bf16_t* VC;
    __device__ __forceinline__ void operator()(const f32x4 (&acc)[2][2][4][2], const Unit& u, int wr, int wc, int fr_in, int fq_in) const {
        int t_ = threadIdx.x; asm volatile("" : "+v"(t_)); const int fr = t_ & 15, fq = (t_ >> 4) & 3;
        const int row0 = u.pm * BM + wr * 64 + fr;
#pragma unroll
        for (int ai = 0; ai < 2; ++ai)
#pragma unroll
            for (int m = 0; m < 4; ++m) {
                const size_t r = (size_t)(row0 + ai * HALF + m * 16);
#pragma unroll
                for (int bj = 0; bj < 2; ++bj) {
                    const int hh = u.pn * 2 + bj;
                    const f32x4 v0 = acc[ai][bj][m][0], v1 = acc[ai][bj][m][1];
                    u32x4 w; w.x = cvt_pk_bf16(v0[0], v0[1]); w.y = cvt_pk_bf16(v0[2], v0[3]); w.z = cvt_pk_bf16(v1[0], v1[1]); w.w = cvt_pk_bf16(v1[2], v1[3]);
                    bf16_t* p = (wc < 2) ? KC + r * 384 + hh * 96 + wc * 32 + 8 * fq : VC + r * 256 + hh * 64 + (wc - 2) * 32 + 8 * fq;
                    *(u32x4*)p = w;
                }
            }
    }
};
template <class Epi, class Sched, bool ALIGN_EPI = false, bool SP2 = false>
__device__ __forceinline__ void gemm_phase(PG8_LAS unsigned char* lds, const Gemm g, const Sched& S, const Epi& E) {
    int tid_ = threadIdx.x; asm volatile("" : "+v"(tid_));
    const int tid = tid_, wid = __builtin_amdgcn_readfirstlane(tid >> 6), lane = tid & 63, wr = wid >> 2, wc = wid & 3, fr = lane & 15, fq = lane >> 4;
    const int K = g.K, nt = K / BK;
    unsigned voffA[2], voffB[2];
#pragma unroll
    for (int i = 0; i < 2; ++i) { int R, C; stage_rc(tid * 16 + i * 8192, R, C); const int Rb = Epi::PERM ? ((R & ~31) + perm32(R & 31)) : R;
        voffA[i] = (unsigned)(R * K + C) * 2u; voffB[i] = (unsigned)(Rb * K + C) * 2u; }
    const size_t kstep = (size_t)(BK * 2);
    const size_t hstep = (size_t)HALF * K * 2;
    const size_t tstep = 2 * hstep;
    const unsigned ldsw = (unsigned)wid * 1024u;
    const int aoff = lds_byte(wr * 64 + fr, fq * 8), boff = lds_byte(wc * 32 + fr, fq * 8);
#define PG8_SA(b, h) (((b) * 2 + (h)) * HTB)
#define PG8_SB(b, h) ((4 + (b) * 2 + (h)) * HTB)
#define PG8_STAGE(bufoff, gbase, voff) do { _Pragma("unroll") for (int _i = 0; _i < 2; ++_i) \
        __builtin_amdgcn_global_load_lds((const unsigned*)((const char*)(gbase) + (voff)[_i]), (PG8_LAS unsigned*)(lds + (bufoff) + ldsw + _i * 8192), 16, 0, 0); } while (0)
#define PG8_LDA(dst, b, h) do { _Pragma("unroll") for (int m = 0; m < 4; ++m) _Pragma("unroll") for (int k = 0; k < 2; ++k) dst[m][k] = *(const PG8_LAS bf16x8*)(lds + PG8_SA(b, h) + aoff + m * 2048 + k * 1024); } while (0)
#define PG8_LDB(dst, b, h) do { _Pragma("unroll") for (int n = 0; n < 2; ++n) _Pragma("unroll") for (int k = 0; k < 2; ++k) dst[n][k] = *(const PG8_LAS bf16x8*)(lds + PG8_SB(b, h) + boff + n * 2048 + k * 1024); } while (0)
#define PG8_MMA(ai, bj, At, Bt) do { __builtin_amdgcn_s_setprio(1); _Pragma("unroll") for (int m = 0; m < 4; ++m) _Pragma("unroll") for (int n = 0; n < 2; ++n) _Pragma("unroll") for (int k = 0; k < 2; ++k) \
        acc[ai][bj][m][n] = __builtin_amdgcn_mfma_f32_16x16x32_bf16(Bt[n][k], At[m][k], acc[ai][bj][m][n], 0, 0, 0); __builtin_amdgcn_s_setprio(0); } while (0)
#define PG8_WAIT_V(n) asm volatile("s_waitcnt vmcnt(" #n ")" ::: "memory")
#define PG8_WAIT_L(n) asm volatile("s_waitcnt lgkmcnt(" #n ")" ::: "memory")
#define PG8_BAR __builtin_amdgcn_s_barrier()
#define PG8_SCHED __builtin_amdgcn_sched_barrier(0)
    Unit cur, nxt; int ui = 0;
    if (!S.next(0, cur)) return;
    f32x4 acc[2][2][4][2];
#pragma unroll
    for (int a = 0; a < 2; ++a)
#pragma unroll
        for (int b = 0; b < 2; ++b)
#pragma unroll
            for (int m = 0; m < 4; ++m)
#pragma unroll
                for (int n = 0; n < 2; ++n) acc[a][b][m][n] = (f32x4){0.f, 0.f, 0.f, 0.f};
    bf16x8 At[4][2], B0[2][2], B1[2][2];
    const char* cA = (const char*)g.A + (size_t)cur.pm * tstep; const char* cB = (const char*)g.Bt + (size_t)cur.pn * tstep;
    S.a_ready(cur);
    if constexpr (SP2) {
        PG8_STAGE(PG8_SB(0, 0), cB, voffB); PG8_STAGE(PG8_SB(0, 1), cB + hstep, voffB); PG8_STAGE(PG8_SA(0, 0), cA, voffA); PG8_STAGE(PG8_SA(0, 1), cA + hstep, voffA);
        if (wr == 1) PG8_BAR;
        PG8_WAIT_V(2); PG8_BAR;
        PG8_STAGE(PG8_SB(1, 0), cB + kstep, voffB); PG8_STAGE(PG8_SA(1, 0), cA + kstep, voffA); PG8_STAGE(PG8_SB(1, 1), cB + hstep + kstep, voffB);
        PG8_WAIT_V(6); PG8_BAR;
    } else {
        PG8_STAGE(PG8_SB(0, 0), cB, voffB); PG8_STAGE(PG8_SA(0, 0), cA, voffA); PG8_STAGE(PG8_SB(0, 1), cB + hstep, voffB); PG8_STAGE(PG8_SA(0, 1), cA + hstep, voffA);
        if (wr == 1) PG8_BAR;
        PG8_WAIT_V(4); PG8_BAR;
        PG8_STAGE(PG8_SB(1, 0), cB + kstep, voffB); PG8_STAGE(PG8_SA(1, 0), cA + kstep, voffA); PG8_STAGE(PG8_SB(1, 1), cB + hstep + kstep, voffB);
        PG8_WAIT_V(6); PG8_BAR;
    }
    for (;;) {
        const bool has_next = S.next(ui + 1, nxt);
        const char* nA = has_next ? (const char*)g.A + (size_t)nxt.pm * tstep : cA; const char* nB = has_next ? (const char*)g.Bt + (size_t)nxt.pn * tstep : cB;
        for (int t = 0; t < nt; t += 2) {
            const bool last = (t == nt - 2);
            const char* a1 = cA + (size_t)(t + 1) * kstep;
            const char* a2 = last ? nA : cA + (size_t)(t + 2) * kstep; const char* b2 = last ? nB : cB + (size_t)(t + 2) * kstep;
            const char* a3 = a2 + kstep; const char* b3 = b2 + kstep;
            if (last && has_next) S.a_ready(nxt);
            if constexpr (SP2) {
            PG8_LDB(B0, 0, 0); PG8_LDB(B1, 0, 1); PG8_SCHED; PG8_LDA(At, 0, 0); PG8_STAGE(PG8_SA(1, 1), a1 + hstep, voffA);
            PG8_WAIT_V(8); PG8_WAIT_L(0); PG8_BAR; PG8_MMA(0, 0, At, B0); PG8_MMA(0, 1, At, B1); PG8_BAR; PG8_SCHED;
            PG8_LDA(At, 0, 1); PG8_STAGE(PG8_SB(0, 0), b2, voffB); PG8_STAGE(PG8_SB(0, 1), b2 + hstep, voffB); PG8_STAGE(PG8_SA(0, 0), a2, voffA);
            PG8_WAIT_V(8); PG8_WAIT_L(0); PG8_BAR; PG8_MMA(1, 0, At, B0); PG8_MMA(1, 1, At, B1); PG8_BAR; PG8_SCHED;
            PG8_LDB(B0, 1, 0); PG8_LDB(B1, 1, 1); PG8_SCHED; PG8_LDA(At, 1, 0); PG8_STAGE(PG8_SA(0, 1), a2 + hstep, voffA);
            PG8_WAIT_V(8); PG8_WAIT_L(0); PG8_BAR; PG8_MMA(0, 0, At, B0); PG8_MMA(0, 1, At, B1); PG8_BAR; PG8_SCHED;
            PG8_LDA(At, 1, 1); PG8_STAGE(PG8_SB(1, 0), b3, voffB); PG8_STAGE(PG8_SB(1, 1), b3 + hstep, voffB); PG8_STAGE(PG8_SA(1, 0), a3, voffA);
            PG8_WAIT_V(8); PG8_WAIT_L(0); PG8_BAR; PG8_MMA(1, 0, At, B0); PG8_MMA(1, 1, At, B1); PG8_BAR; PG8_SCHED;
            } else {
            PG8_LDB(B0, 0, 0); PG8_SCHED; PG8_LDA(At, 0, 0); PG8_STAGE(PG8_SA(1, 1), a1 + hstep, voffA);
            PG8_WAIT_L(8); PG8_BAR; PG8_WAIT_L(0); PG8_MMA(0, 0, At, B0); PG8_BAR; PG8_SCHED;
            PG8_LDB(B1, 0, 1); PG8_STAGE(PG8_SB(0, 0), b2, voffB);
            PG8_BAR; PG8_WAIT_L(0); PG8_MMA(0, 1, At, B1); PG8_BAR;
            PG8_LDA(At, 0, 1); PG8_STAGE(PG8_SA(0, 0), a2, voffA);
            PG8_BAR; PG8_WAIT_L(0); PG8_MMA(1, 0, At, B0); PG8_BAR; PG8_SCHED;
            PG8_STAGE(PG8_SB(0, 1), b2 + hstep, voffB);
            PG8_WAIT_V(6); PG8_BAR; PG8_MMA(1, 1, At, B1); PG8_BAR;
            PG8_LDB(B0, 1, 0); PG8_SCHED; PG8_LDA(At, 1, 0); PG8_STAGE(PG8_SA(0, 1), a2 + hstep, voffA);
            PG8_WAIT_L(8); PG8_BAR; PG8_WAIT_L(0); PG8_MMA(0, 0, At, B0); PG8_BAR; PG8_SCHED;
            PG8_LDB(B1, 1, 1); PG8_STAGE(PG8_SB(1, 0), b3, voffB);
            PG8_BAR; PG8_WAIT_L(0); PG8_MMA(0, 1, At, B1); PG8_BAR;
            PG8_LDA(At, 1, 1); PG8_STAGE(PG8_SA(1, 0), a3, voffA);
            PG8_BAR; PG8_WAIT_L(0); PG8_MMA(1, 0, At, B0); PG8_BAR; PG8_SCHED;
            PG8_STAGE(PG8_SB(1, 1), b3 + hstep, voffB);
            PG8_WAIT_V(6); PG8_BAR; PG8_MMA(1, 1, At, B1); PG8_BAR;
            }
        }
        if constexpr (ALIGN_EPI) { if (wr == 0) PG8_BAR; }
        if constexpr (!Epi::AFTER_DRAIN) { E(acc, cur, wr, wc, fr, fq); S.done(cur); }
        if (!has_next) break;
#pragma unroll
        for (int a = 0; a < 2; ++a)
#pragma unroll
            for (int b = 0; b < 2; ++b)
#pragma unroll
                for (int m = 0; m < 4; ++m)
#pragma unroll
                    for (int n = 0; n < 2; ++n) acc[a][b][m][n] = (f32x4){0.f, 0.f, 0.f, 0.f};
        cur = nxt; cA = nA; cB = nB; ++ui;
        if constexpr (ALIGN_EPI) { if (wr == 1) PG8_BAR; }
    }
    PG8_WAIT_V(0);
    if constexpr (!ALIGN_EPI) { if (wr == 0) PG8_BAR; }
    PG8_BAR;
    if constexpr (Epi::AFTER_DRAIN) { E.fused(acc, cur, wr, wc, fr, fq, lds, wid, lane); S.done(cur); }
#undef PG8_SA
#undef PG8_SB
#undef PG8_STAGE
#undef PG8_LDA
#undef PG8_LDB
#undef PG8_MMA
#undef PG8_WAIT_V
#undef PG8_WAIT_L
#undef PG8_BAR
#undef PG8_SCHED
}
}
__device__ __forceinline__ void transpose_item(const float* W, int K, int N, bf16_t* WT, int k0, int n0, int drow0, LAS float* scr, int lane) {
#pragma unroll 8
    for (int i = 0; i < 32; ++i) { const int kk = 2 * i + (lane >> 5); scr[kk * 33 + (lane & 31)] = W[(size_t)(k0 + kk) * N + n0 + (lane & 31)]; }
    asm volatile("s_waitcnt lgkmcnt(0)" ::: "memory");
    const int c = lane & 7;
#pragma unroll
    for (int j = 0; j < 4; ++j) { const int n = (lane >> 3) + 8 * j; const LAS float* s = scr + (8 * c) * 33 + n;
        u32x4 o; o.x = pk2(s[0 * 33], s[1 * 33]); o.y = pk2(s[2 * 33], s[3 * 33]); o.z = pk2(s[4 * 33], s[5 * 33]); o.w = pk2(s[6 * 33], s[7 * 33]);
        *(u32x4*)(WT + (size_t)(drow0 + n) * K + k0 + 8 * c) = o; }
    asm volatile("s_waitcnt lgkmcnt(0)" ::: "memory");
}
template <bool GU> __device__ __forceinline__ void transpose_matrix_item(const float* W, int K, int N, bf16_t* WT, int item, LAS float* scr, int lane) {
    const int nblk = N / 32, kb = item / nblk, nb = item % nblk, n0 = 32 * nb;
    int drow0 = n0;
    if (GU) { const int isu = n0 >= DFF ? 1 : 0, ff0 = n0 - isu * DFF; drow0 = 256 * (ff0 >> 7) + 128 * isu + (ff0 & 127); }
    transpose_item(W, K, N, WT, 64 * kb, n0, drow0, scr, lane);
}

__device__ __forceinline__ int t5_bucket_dev(int rel) {
    const int n = rel < 0 ? -rel : rel;
    int b = n < 8 ? n : n < 12 ? 8 : n < 16 ? 9 : n < 23 ? 10 : n < 32 ? 11 : n < 46 ? 12 : n < 64 ? 13 : n < 91 ? 14 : 15;
    return b + (rel > 0 ? 16 : 0);
}
struct AttnArgs { const bf16_t* U; const bf16_t* KC; const bf16_t* VC; bf16_t* O; const float* rel_bias; const float* dl; const float* gsub; const float* sinks; float lam_init; };

__device__ __forceinline__ float max3f(float a, float b, float c) { float r; asm("v_max3_f32 %0, %1, %2, %3" : "=v"(r) : "v"(a), "v"(b), "v"(c)); return r; }
__device__ __forceinline__ float swapmax(float m) { auto rr = __builtin_amdgcn_permlane32_swap(__float_as_uint(m), __float_as_uint(m), false, false); return fmaxf(__uint_as_float(rr[0]), __uint_as_float(rr[1])); }
__device__ __forceinline__ float swapsum(float m) { auto rr = __builtin_amdgcn_permlane32_swap(__float_as_uint(m), __float_as_uint(m), false, false); return __uint_as_float(rr[0]) + __uint_as_float(rr[1]); }
typedef float f32x2_t __attribute__((ext_vector_type(2))); typedef __bf16 bf16x2_t __attribute__((ext_vector_type(2)));
__device__ __forceinline__ unsigned cvtpk(float lo, float hi) { f32x2_t v = {lo, hi}; bf16x2_t b = __builtin_convertvector(v, bf16x2_t); return __builtin_bit_cast(unsigned, b); }

template <int MODE> __device__ __forceinline__ void attn_unit(LAS unsigned char* lds, const int uidx, const AttnArgs& A) {
    constexpr int DQK = MODE == 1 ? 96 : 64, DV = MODE == 0 ? 128 : 64;
    constexpr int KCH = MODE == 0 ? 16 : (MODE == 1 ? 24 : 8), VCH = MODE == 2 ? 8 : 16;
    constexpr int KSTR = KCH * 16 + 16, VSTR = 320;
    constexpr int KSOFF = MODE == 0 ? 128 : (MODE == 1 ? 192 : 0), VSOFF = MODE == 1 ? 128 : 0;
    constexpr int NKL = KCH * 64 / NTHR, NVL = VCH * 64 / NTHR;
    constexpr int KOFF = 0, VOFF = 25600, BUFB = 46080, TABOFF = 92160;
    constexpr int NKC = DQK / 16, NDB = DV / 32;
    int tid = threadIdx.x; asm volatile("" : "+v"(tid));
    const int lane = tid & 63, wid = __builtin_amdgcn_readfirstlane(tid >> 6), r32 = lane & 31, hi = lane >> 5, qg = wid & 3, st = wid >> 2;
    const int qb = uidx % 65, bh = uidx / 65;
    const int NH = MODE == 0 ? 4 : 2;
    const int b = bh / NH, hx = bh % NH;
    const size_t row0 = (size_t)b * LP;
    const bf16_t *Kg, *Vg, *Qg; int kld, vld;
    if (MODE == 0) { Kg = A.U + 512 + hx * 128; kld = DIN; Vg = A.U + 1024 + hx * 128; vld = DIN; Qg = A.U + hx * 128 + st * 64; }
    else if (MODE == 1) { Kg = A.KC + hx * 192; kld = 384; Vg = A.VC + hx * 128; vld = 256; Qg = A.U + 2048 + (2 * hx + st) * 96; }
    else { Kg = A.U + 1792 + hx * 64; kld = DIN; Vg = A.U + 1920 + hx * 64; vld = DIN; Qg = A.U + 1536 + (2 * hx + st) * 64; }
    int t0 = 1, t1 = 130;
    if (MODE == 2) { t0 = 2 * (qb - 1); if (t0 < 1) t0 = 1; t1 = 2 * (qb + 2); if (t1 > 130) t1 = 130; }
    LAS float* tab = (LAS float*)(lds + TABOFF);
    if (MODE != 1) {
        const int rel = tid - 256; const int bk = t5_bucket_dev(rel);
        if (MODE == 0) { tab[tid] = A.rel_bias[bk * 8 + hx] * LOG2E; }
        else { const bool okw = (rel <= 128 && rel >= -128);
            tab[tid] = okw ? A.rel_bias[bk * 8 + 4 + 2 * hx] * LOG2E : NEGBIG; tab[512 + tid] = okw ? A.rel_bias[bk * 8 + 4 + 2 * hx + 1] * LOG2E : NEGBIG; }
    }
    const int qslot0 = qb * 128 + qg * 32;
    bf16x8 qf[NKC];
    { const bf16_t* qp = Qg + (row0 + qslot0 + r32) * DIN + hi * 8;
#pragma unroll
      for (int kc = 0; kc < NKC; ++kc) qf[kc] = *(const bf16x8*)(qp + kc * 16); }
    int ksrc[NKL], kdst[NKL], vsrc[NVL], vdst[NVL];
#pragma unroll
    for (int i = 0; i < NKL; ++i) { const int id = tid + NTHR * i, key = id / KCH, ch = id % KCH; ksrc[i] = key * kld + ch * 8; kdst[i] = KOFF + key * KSTR + ch * 16; }
#pragma unroll
    for (int i = 0; i < NVL; ++i) { const int id = tid + NTHR * i, key = id / VCH, ch = id % VCH; vsrc[i] = key * vld + ch * 8; vdst[i] = VOFF + key * VSTR + ch * 16; }
    u32x4 kst[NKL], vst[NVL];
#define ATT_ISSUE(t) do { const bf16_t* kp_ = Kg + (row0 + 64 * (size_t)(t)) * kld; const bf16_t* vp_ = Vg + (row0 + 64 * (size_t)(t)) * vld; \
        _Pragma("unroll") for (int i = 0; i < NKL; ++i) kst[i] = *(const u32x4*)(kp_ + ksrc[i]); \
        _Pragma("unroll") for (int i = 0; i < NVL; ++i) vst[i] = *(const u32x4*)(vp_ + vsrc[i]); } while (0)
#define ATT_COMMIT(buf) do { LAS unsigned char* bb_ = lds + (buf) * BUFB; \
        _Pragma("unroll") for (int i = 0; i < NKL; ++i) *(LAS u32x4*)(bb_ + kdst[i]) = kst[i]; \
        _Pragma("unroll") for (int i = 0; i < NVL; ++i) *(LAS u32x4*)(bb_ + vdst[i]) = vst[i]; } while (0)
    f32x16 o[NDB];
#pragma unroll
    for (int d = 0; d < NDB; ++d)
#pragma unroll
        for (int r = 0; r < 16; ++r) o[d][r] = 0.f;
    float mref = NEGBIG, lsum = 0.f;
    const int kfrag = st * KSOFF + r32 * KSTR + hi * 16;
    const int vfrag = st * VSOFF + (4 * hi + ((lane & 15) >> 2)) * VSTR + ((lane >> 4) & 1) * 32 + (lane & 3) * 8;
    const LAS float* mytab = tab + (MODE == 2 ? st * 512 : 0);
    ATT_ISSUE(t0); ATT_COMMIT(0); __syncthreads();
    for (int t = t0; t < t1; ++t) {
        const int buf = (t - t0) & 1;
        if (t + 1 < t1) ATT_ISSUE(t + 1);
        const LAS unsigned char* kb = lds + buf * BUFB + KOFF + kfrag;
        const LAS unsigned char* vb = lds + buf * BUFB + VOFF + vfrag;
        const int ks = 64 * t;
        bool near = (MODE == 2); float cb = 0.f;
        if (MODE == 0) { const int maxrel = ks + 63 - qslot0, minrel = ks - (qslot0 + 31);
            if (maxrel <= -91) cb = mytab[0]; else if (minrel >= 91) cb = mytab[511]; else near = true; }
        f32x16 p0, p1;
#pragma unroll
        for (int r = 0; r < 16; ++r) { p0[r] = cb; p1[r] = cb; }
#pragma unroll
        for (int kc = 0; kc < NKC; ++kc) {
            const bf16x8 a0 = *(const LAS bf16x8*)(kb + kc * 32), a1 = *(const LAS bf16x8*)(kb + 32 * KSTR + kc * 32);
            p0 = __builtin_amdgcn_mfma_f32_32x32x16_bf16(a0, qf[kc], p0, 0, 0, 0);
            p1 = __builtin_amdgcn_mfma_f32_32x32x16_bf16(a1, qf[kc], p1, 0, 0, 0);
        }
        if (MODE != 1 && near) {
            const int relb = ks + 4 * hi - (qslot0 + r32) + 256;
#pragma unroll
            for (int r = 0; r < 16; ++r) { const int c = (r & 3) + 8 * (r >> 2);
                int i0 = relb + c, i1 = relb + c + 32; i0 = i0 < 0 ? 0 : (i0 > 511 ? 511 : i0); i1 = i1 < 0 ? 0 : (i1 > 511 ? 511 : i1);
                p0[r] += mytab[i0]; p1[r] += mytab[i1]; }
        }
        if (t == 1) {
#pragma unroll
            for (int r = 0; r < 16; ++r) { const int c = (r & 3) + 8 * (r >> 2) + 4 * hi; p0[r] = NEGBIG; if (c < 16) p1[r] = NEGBIG; }
        }
        float mx = fmaxf(p0[0], p1[0]);
#pragma unroll
        for (int r = 1; r < 16; ++r) mx = fmaxf(mx, fmaxf(p0[r], p1[r]));
        mx = swapmax(mx);
        if (__any(mx > mref + 8.0f)) {
            const float mn = fmaxf(mref, mx), f = __builtin_amdgcn_exp2f(mref - mn); mref = mn; lsum *= f;
#pragma unroll
            for (int d = 0; d < NDB; ++d)
#pragma unroll
                for (int r = 0; r < 16; ++r) o[d][r] *= f;
        }
        float ps = 0.f;
#pragma unroll
        for (int r = 0; r < 16; ++r) { p0[r] = __builtin_amdgcn_exp2f(p0[r] - mref); p1[r] = __builtin_amdgcn_exp2f(p1[r] - mref); ps += p0[r] + p1[r]; }
        lsum += ps;
        bf16x8 pk[4];
        { u32x4 w;
          w.x = cvtpk(p0[0], p0[1]); w.y = cvtpk(p0[2], p0[3]); w.z = cvtpk(p0[4], p0[5]); w.w = cvtpk(p0[6], p0[7]); pk[0] = __builtin_bit_cast(bf16x8, w);
          w.x = cvtpk(p0[8], p0[9]); w.y = cvtpk(p0[10], p0[11]); w.z = cvtpk(p0[12], p0[13]); w.w = cvtpk(p0[14], p0[15]); pk[1] = __builtin_bit_cast(bf16x8, w);
          w.x = cvtpk(p1[0], p1[1]); w.y = cvtpk(p1[2], p1[3]); w.z = cvtpk(p1[4], p1[5]); w.w = cvtpk(p1[6], p1[7]); pk[2] = __builtin_bit_cast(bf16x8, w);
          w.x = cvtpk(p1[8], p1[9]); w.y = cvtpk(p1[10], p1[11]); w.z = cvtpk(p1[12], p1[13]); w.w = cvtpk(p1[14], p1[15]); pk[3] = __builtin_bit_cast(bf16x8, w); }
#pragma unroll
        for (int d = 0; d < NDB; ++d)
#pragma unroll
            for (int c = 0; c < 4; ++c) {
                const v4i16_t lo = __builtin_amdgcn_ds_read_tr16_b64_v4i16((LAS v4i16_t*)(vb + c * 16 * VSTR + d * 64));
                const v4i16_t hh = __builtin_amdgcn_ds_read_tr16_b64_v4i16((LAS v4i16_t*)(vb + c * 16 * VSTR + 8 * VSTR + d * 64));
                const bf16x8 vf = (bf16x8){lo[0], lo[1], lo[2], lo[3], hh[0], hh[1], hh[2], hh[3]};
                o[d] = __builtin_amdgcn_mfma_f32_32x32x16_bf16(vf, pk[c], o[d], 0, 0, 0);
            }
        if (t + 1 < t1) ATT_COMMIT(buf ^ 1);
        __syncthreads();
    }
#undef ATT_ISSUE
#undef ATT_COMMIT
    float lt = swapsum(lsum);
    if (MODE == 2) lt += __builtin_amdgcn_exp2f(A.sinks[2 * hx + st] * LOG2E - mref);
    const float inv = 1.0f / lt;
#pragma unroll
    for (int d = 0; d < NDB; ++d)
#pragma unroll
        for (int r = 0; r < 16; ++r) o[d][r] *= inv;
    const size_t orow = row0 + qslot0 + r32;
    if (MODE == 0) {
        LAS float* X = (LAS float*)lds;
        if (st == 1) {
#pragma unroll
            for (int d = 0; d < NDB; ++d)
#pragma unroll
                for (int r = 0; r < 16; ++r) X[(qg * 64 + d * 16 + r) * 64 + lane] = o[d][r];
        }
        __syncthreads();
        if (st == 0) {
            const float sx = wave_sum(A.dl[lane] * A.dl[64 + lane], lane), sy = wave_sum(A.dl[128 + lane] * A.dl[192 + lane], lane);
            const float lam = __expf(sx) - __expf(sy) + A.lam_init;
            float ss = 0.f;
#pragma unroll
            for (int d = 0; d < NDB; ++d)
#pragma unroll
                for (int r = 0; r < 16; ++r) { const float v = o[d][r] - lam * X[(qg * 64 + d * 16 + r) * 64 + lane]; o[d][r] = v; ss += v * v; }
            ss = swapsum(ss);
            const float rs = (1.0f / sqrtf(ss * (1.0f / 128.0f) + EPSN)) * (1.0f - A.lam_init);
            bf16_t* op = A.O + orow * DM + hx * 128 + 4 * hi;
#pragma unroll
            for (int d = 0; d < NDB; ++d)
#pragma unroll
                for (int g4 = 0; g4 < 4; ++g4) {
                    const f32x4 gv = *(const f32x4*)(A.gsub + d * 32 + 8 * g4 + 4 * hi);
                    u32x2 w; w.x = cvtpk(o[d][4 * g4] * rs * gv[0], o[d][4 * g4 + 1] * rs * gv[1]); w.y = cvtpk(o[d][4 * g4 + 2] * rs * gv[2], o[d][4 * g4 + 3] * rs * gv[3]);
                    *(u32x2*)(op + d * 32 + 8 * g4) = w;
                }
        }
    } else {
        bf16_t* op = A.O + orow * DM + (MODE == 1 ? 768 : 512) + (2 * hx + st) * 64 + 4 * hi;
#pragma unroll
        for (int d = 0; d < NDB; ++d)
#pragma unroll
            for (int g4 = 0; g4 < 4; ++g4) {
                u32x2 w; w.x = cvtpk(o[d][4 * g4], o[d][4 * g4 + 1]); w.y = cvtpk(o[d][4 * g4 + 2], o[d][4 * g4 + 3]);
                *(u32x2*)(op + d * 32 + 8 * g4) = w;
            }
    }
    __syncthreads();
}
#ifndef ATT_PF
#define ATT_PF 4
#endif
template <int MODE> __device__ __forceinline__ void attn_unit4(LAS unsigned char* lds, const int uidx, const AttnArgs& A) {
    constexpr int DQK = MODE == 1 ? 96 : 64, DV = MODE == 0 ? 128 : 64;
    constexpr int KCH = MODE == 0 ? 16 : (MODE == 1 ? 24 : 8), VCH = MODE == 2 ? 8 : 16;
    constexpr int KSTR = KCH * 16 + 16, VSTR = 320;
    constexpr int KSOFF = MODE == 0 ? 128 : (MODE == 1 ? 192 : 0), VSOFF = MODE == 1 ? 128 : 0;
    constexpr int NKL = KCH * 64 / NTHR, NVL = VCH * 64 / NTHR;
    constexpr int KSTG = 25600, VBASE = 2 * KSTG, VSTG = 20480, TABOFF = VBASE + 3 * VSTG;
    constexpr int NKC = DQK / 16, NDB = DV / 32;
    int tid = threadIdx.x; asm volatile("" : "+v"(tid));
    float negbig = NEGBIG; asm volatile("" : "+v"(negbig));
    const int lane = tid & 63, wid = __builtin_amdgcn_readfirstlane(tid >> 6), r32 = lane & 31, hi = lane >> 5, qg = wid & 3, st = wid >> 2;
    const int qb = uidx % 65, bh = uidx / 65;
    const int NH = MODE == 0 ? 4 : 2;
    const int b = bh / NH, hx = bh % NH;
    const size_t row0 = (size_t)b * LP;
    const GAS bf16_t *Kg, *Vg, *Qg; int kld, vld;
    if (MODE == 0) { Kg = (const GAS bf16_t*)A.U + 512 + hx * 128; kld = DIN; Vg = (const GAS bf16_t*)A.U + 1024 + hx * 128; vld = DIN; Qg = (const GAS bf16_t*)A.U + hx * 128 + st * 64; }
    else if (MODE == 1) { Kg = (const GAS bf16_t*)A.KC + hx * 192; kld = 384; Vg = (const GAS bf16_t*)A.VC + hx * 128; vld = 256; Qg = (const GAS bf16_t*)A.U + 2048 + (2 * hx + st) * 96; }
    else { Kg = (const GAS bf16_t*)A.U + 1792 + hx * 64; kld = DIN; Vg = (const GAS bf16_t*)A.U + 1920 + hx * 64; vld = DIN; Qg = (const GAS bf16_t*)A.U + 1536 + (2 * hx + st) * 64; }
    int t0 = 1, t1 = 130;
    if (MODE == 2) { t0 = 2 * (qb - 1); if (t0 < 1) t0 = 1; t1 = 2 * (qb + 2); if (t1 > 130) t1 = 130; }
    LAS float* tab = (LAS float*)(lds + TABOFF);
    if (MODE != 1) {
        const int rel = tid - 256; const int bk = t5_bucket_dev(rel);
        if (MODE == 0) { tab[tid] = A.rel_bias[bk * 8 + hx] * LOG2E; }
        else { const bool okw = (rel <= 128 && rel >= -128);
            tab[tid] = okw ? A.rel_bias[bk * 8 + 4 + 2 * hx] * LOG2E : negbig; tab[512 + tid] = okw ? A.rel_bias[bk * 8 + 4 + 2 * hx + 1] * LOG2E : negbig; }
    }
    const int qslot0 = qb * 128 + qg * 32;
    bf16x8 qf[NKC];
    { const GAS bf16_t* qp = Qg + (row0 + qslot0 + r32) * DIN + hi * 8;
#pragma unroll
      for (int kc = 0; kc < NKC; ++kc) qf[kc] = *(const GAS bf16x8*)(qp + kc * 16); }
    int ksrc[NKL], kdst[NKL], vsrc[NVL], vdst[NVL];
#pragma unroll
    for (int i = 0; i < NKL; ++i) { const int id = tid + NTHR * i, key = id / KCH, ch = id % KCH; ksrc[i] = key * kld + ch * 8; kdst[i] = key * KSTR + ch * 16; }
#pragma unroll
    for (int i = 0; i < NVL; ++i) { const int id = tid + NTHR * i, key = id / VCH, ch = id % VCH; vsrc[i] = key * vld + ch * 8; vdst[i] = VBASE + key * VSTR + ch * 16; }
    u32x4 kst[NKL], vst[NVL];
#define A2_ISSUE_K(t) do { int tc_ = (t); tc_ = tc_ < t1 ? tc_ : t1 - 1; const GAS bf16_t* kp_ = Kg + (row0 + 64 * (size_t)tc_) * kld; \
        _Pragma("unroll") for (int i = 0; i < NKL; ++i) kst[i] = *(const GAS u32x4*)(kp_ + ksrc[i]); } while (0)
#define A2_ISSUE_V(t) do { int tc_ = (t); tc_ = tc_ < t1 ? tc_ : t1 - 1; const GAS bf16_t* vp_ = Vg + (row0 + 64 * (size_t)tc_) * vld; \
        _Pragma("unroll") for (int i = 0; i < NVL; ++i) vst[i] = *(const GAS u32x4*)(vp_ + vsrc[i]); } while (0)
#define A2_COMMIT_K(slot) do { LAS unsigned char* bb_ = lds + (slot) * KSTG; _Pragma("unroll") for (int i = 0; i < NKL; ++i) *(LAS u32x4*)(bb_ + kdst[i]) = kst[i]; } while (0)
#define A2_COMMIT_V(slot) do { LAS unsigned char* bb_ = lds + (slot) * VSTG; _Pragma("unroll") for (int i = 0; i < NVL; ++i) *(LAS u32x4*)(bb_ + vdst[i]) = vst[i]; } while (0)
#define A2_TILE_BIAS(t, cbv, nearv) do { cbv = 0.f; nearv = (MODE == 2); if (MODE == 0) { const int ks_ = 64 * (t); const int maxrel_ = ks_ + 63 - qslot0, minrel_ = ks_ - (qslot0 + 31); \
        const bool lf_ = maxrel_ <= -91, rt_ = minrel_ >= 91; cbv = lf_ ? tabL : (rt_ ? tabR : 0.f); nearv = !(lf_ || rt_); } } while (0)
#define A2_QK(S0, S1, slot, cbv) do { const LAS unsigned char* kb_ = lds + (slot) * KSTG + kfrag; \
        _Pragma("unroll") for (int r = 0; r < 16; ++r) { S0[r] = cbv; S1[r] = cbv; } \
        _Pragma("unroll") for (int kc = 0; kc < NKC; ++kc) { const bf16x8 a0_ = *(const LAS bf16x8*)(kb_ + kc * 32), a1_ = *(const LAS bf16x8*)(kb_ + 32 * KSTR + kc * 32); \
            S0 = __builtin_amdgcn_mfma_f32_32x32x16_bf16(a0_, qf[kc], S0, 0, 0, 0); S1 = __builtin_amdgcn_mfma_f32_32x32x16_bf16(a1_, qf[kc], S1, 0, 0, 0); } } while (0)
#define A2_PV(slot, PK) do { const LAS unsigned char* vb_ = lds + VBASE + (slot) * VSTG + vfrag; \
        _Pragma("unroll") for (int d = 0; d < NDB; ++d) _Pragma("unroll") for (int c = 0; c < 4; ++c) { \
            const v4i16_t lo_ = __builtin_amdgcn_ds_read_tr16_b64_v4i16((LAS v4i16_t*)(vb_ + c * 16 * VSTR + d * 64)); \
            const v4i16_t hh_ = __builtin_amdgcn_ds_read_tr16_b64_v4i16((LAS v4i16_t*)(vb_ + c * 16 * VSTR + 8 * VSTR + d * 64)); \
            const bf16x8 vf_ = (bf16x8){lo_[0], lo_[1], lo_[2], lo_[3], hh_[0], hh_[1], hh_[2], hh_[3]}; \
            o[d] = __builtin_amdgcn_mfma_f32_32x32x16_bf16(vf_, __builtin_bit_cast(bf16x8, PK[c]), o[d], 0, 0, 0); } } while (0)
    f32x16 o[NDB];
#pragma unroll
    for (int d = 0; d < NDB; ++d)
#pragma unroll
        for (int r = 0; r < 16; ++r) o[d][r] = 0.f;
    float lsum = 0.f;
    const int kfrag = st * KSOFF + r32 * KSTR + hi * 16;
    const int vfrag = st * VSOFF + (4 * hi + ((lane & 15) >> 2)) * VSTR + ((lane >> 4) & 1) * 32 + (lane & 3) * 8;
    const LAS float* mytab = tab + (MODE == 2 ? st * 512 : 0);
    {
      u32x4 kst2[NKL];
      A2_ISSUE_K(t0); A2_ISSUE_V(t0);
      { const GAS bf16_t* kp_ = Kg + (row0 + 64 * (size_t)(t0 + 1)) * kld;
#pragma unroll
        for (int i = 0; i < NKL; ++i) kst2[i] = *(const GAS u32x4*)(kp_ + ksrc[i]); }
      A2_COMMIT_K(t0 & 1); A2_COMMIT_V(0);
      { LAS unsigned char* bb_ = lds + ((t0 + 1) & 1) * KSTG;
#pragma unroll
        for (int i = 0; i < NKL; ++i) *(LAS u32x4*)(bb_ + kdst[i]) = kst2[i]; } }
    __syncthreads();
    float tabL = 0.f, tabR = 0.f; if (MODE == 0) { tabL = mytab[0]; tabR = mytab[511]; }
    f32x16 s0, s1, n0, n1; u32x4 pk[4]; float fprev = 1.0f, fcur = 1.0f;
#define A4_BIAS(t, SA, SB) do { \
        const int relb = 64 * (t) + 4 * hi - (qslot0 + r32) + 256; \
        _Pragma("unroll") for (int r = 0; r < 16; ++r) { const int c = (r & 3) + 8 * (r >> 2); \
            int i0 = relb + c, i1 = relb + c + 32; i0 = i0 < 0 ? 0 : (i0 > 511 ? 511 : i0); i1 = i1 < 0 ? 0 : (i1 > 511 ? 511 : i1); \
            SA[r] += mytab[i0]; SB[r] += mytab[i1]; } } while (0)
    float cbc; bool nearc;
    A2_TILE_BIAS(t0, cbc, nearc);
    { const float zero_ = 0.f; A2_QK(s0, s1, t0 & 1, zero_); }
    __syncthreads();
    if (MODE != 1 && nearc) A4_BIAS(t0, s0, s1);
    if (t0 == 1) {
#pragma unroll
        for (int r = 0; r < 16; ++r) { const int c = (r & 3) + 8 * (r >> 2) + 4 * hi; s0[r] = negbig; if (c < 16) s1[r] = negbig; }
    }
    float mref;
    { float mx = fmaxf(s0[0], s1[0]);
#pragma unroll
      for (int r = 1; r < 16; ++r) mx = fmaxf(mx, fmaxf(s0[r], s1[r]));
      mx = swapmax(mx) + cbc; mref = fmaxf(mx, -30.0f);
      const float sh = cbc - mref;
#pragma unroll
      for (int r = 0; r < 16; ++r) { s0[r] += sh; s1[r] += sh; } }
    constexpr bool USE_NEGC = (MODE != 0);
    f32x16 negc;
    { float cb1; bool nr1; A2_TILE_BIAS(t0 + 1, cb1, nr1); const float nv = cb1 - mref;
#pragma unroll
      for (int r = 0; r < 16; ++r) { n0[r] = nv; n1[r] = nv; negc[r] = nv; } }
    int vs_prev = 2, vs_cur = 0, vs_next = 1;
#pragma unroll
    for (int c = 0; c < 4; ++c) pk[c] = (u32x4){0u, 0u, 0u, 0u};
    bf16x8 fan[ATT_PF];
    constexpr int NM = 2 * NKC + 4 * NDB;
    constexpr int EPS = (MODE == 2) ? 4 : 2;
    constexpr int PF = ATT_PF;
    constexpr int NPV = 4 * NDB;
    constexpr int GE = 8 / EPS;
    constexpr int GSTEP = GE > NDB ? GE : NDB;
    constexpr int GF = (MODE == 0) ? 4 : 2;
    static_assert(PF <= NPV, "prefetch");
#define A3_LOADF(i) do { if ((i) >= NPV) { const int j_ = (i) - NPV; fa[(i)] = *(const LAS bf16x8*)(kb_ + (j_ & 1) * 32 * KSTR + (j_ >> 1) * 32); } \
            else { const int c_ = (i) / NDB, d_ = (i) % NDB; \
                const v4i16_t lo_ = __builtin_amdgcn_ds_read_tr16_b64_v4i16((LAS v4i16_t*)(vb_ + c_ * 16 * VSTR + d_ * 64)); \
                const v4i16_t hh_ = __builtin_amdgcn_ds_read_tr16_b64_v4i16((LAS v4i16_t*)(vb_ + c_ * 16 * VSTR + 8 * VSTR + d_ * 64)); \
                fa[(i)] = (bf16x8){lo_[0], lo_[1], lo_[2], lo_[3], hh_[0], hh_[1], hh_[2], hh_[3]}; } } while (0)
#define A3_BODY(t, SC0, SC1, SN0, SN1) do { \
        if (__any(fprev != 1.0f)) { \
            _Pragma("unroll") for (int d = 0; d < NDB; ++d) _Pragma("unroll") for (int r = 0; r < 16; ++r) o[d][r] *= fprev; } \
        float cb1_, cb2_; bool nr1_, nr2_; \
        A2_TILE_BIAS((t) + 1, cb1_, nr1_); A2_TILE_BIAS((t) + 2, cb2_, nr2_); \
        const float nvn_ = cb2_ - mref;                         \
        const LAS unsigned char* kb_ = lds + (((t) + 1) & 1) * KSTG + kfrag; \
        const LAS unsigned char* vb_ = lds + VBASE + (((t) > t0) ? vs_prev : vs_cur) * VSTG + vfrag; \
        bf16x8 fa[NM]; \
        _Pragma("unroll") for (int i = 0; i < PF; ++i) fa[i] = fan[i]; \
        float ps = 0.f, eprev = 0.f; \
        __builtin_amdgcn_sched_barrier(0); \
        _Pragma("unroll") for (int i = 0; i < NM; ++i) { \
            if (i + PF < NM) A3_LOADF(i + PF); \
            if (i < NPV) { const int c = i / NDB, d = i % NDB; o[d] = __builtin_amdgcn_mfma_f32_32x32x16_bf16(fa[i], __builtin_bit_cast(bf16x8, pk[c]), o[d], 0, 0, 0); } \
            else { const int j = i - NPV; if (j & 1) SN1 = __builtin_amdgcn_mfma_f32_32x32x16_bf16(fa[i], qf[j >> 1], (USE_NEGC && j == 1) ? negc : SN1, 0, 0, 0); \
                                          else SN0 = __builtin_amdgcn_mfma_f32_32x32x16_bf16(fa[i], qf[j >> 1], (USE_NEGC && j == 0) ? negc : SN0, 0, 0, 0); } \
            _Pragma("unroll") for (int e = 0; e < 32; ++e) { \
                if (NDB + (e * (NM - NDB)) / 32 == i) { \
                    const float ev = __builtin_amdgcn_exp2f(e < 16 ? SC0[e & 15] : SC1[e & 15]); ps += ev; \
                    if (e & 1) pk[e >> 3][(e >> 1) & 3] = cvtpk(eprev, ev); else eprev = ev; } } \
            if (i == 1) A2_ISSUE_K((t) + 2); \
            if (i == 2) A2_ISSUE_V((t) + 1); \
            if (i == NM - 4) A2_COMMIT_K((t) & 1); \
            if (i == NM - 2) A2_COMMIT_V(vs_next); \
            __builtin_amdgcn_sched_barrier(0); \
        } \
        asm volatile("" :: "v"(pk[0]), "v"(pk[1]), "v"(pk[2]), "v"(pk[3]), "v"(ps)); \
        if (!USE_NEGC) { _Pragma("unroll") for (int r = 0; r < 16; ++r) { SC0[r] = nvn_; SC1[r] = nvn_; } } \
        { const LAS unsigned char* vbn_ = lds + VBASE + vs_cur * VSTG + vfrag;        \
          _Pragma("unroll") for (int i = 0; i < PF; ++i) { const int c_ = i / NDB, d_ = i % NDB; \
            const v4i16_t lo_ = __builtin_amdgcn_ds_read_tr16_b64_v4i16((LAS v4i16_t*)(vbn_ + c_ * 16 * VSTR + d_ * 64)); \
            const v4i16_t hh_ = __builtin_amdgcn_ds_read_tr16_b64_v4i16((LAS v4i16_t*)(vbn_ + c_ * 16 * VSTR + 8 * VSTR + d_ * 64)); \
            fan[i] = (bf16x8){lo_[0], lo_[1], lo_[2], lo_[3], hh_[0], hh_[1], hh_[2], hh_[3]}; } } \
        lsum = lsum * fcur + ps; \
        fprev = fcur; fcur = 1.0f; \
          \
        if (MODE != 1 && nr1_) A4_BIAS((t) + 1, SN0, SN1); \
        if ((t) + 1 < t1 && __any(ps > 1.0e12f)) { float dl = ps > 1.0e12f ? floorf(__builtin_amdgcn_logf(ps)) : 0.f; dl = swapmax(dl); \
            mref += dl; fcur = __builtin_amdgcn_exp2f(-dl); const float nv2_ = cb2_ - mref; \
            _Pragma("unroll") for (int r = 0; r < 16; ++r) { SN0[r] -= dl; SN1[r] -= dl; SC0[r] = nv2_; SC1[r] = nv2_; negc[r] = nv2_; } } \
        __syncthreads(); \
        { const int tmp = vs_prev; vs_prev = vs_cur; vs_cur = vs_next; vs_next = tmp; } \
    } while (0)
    { const LAS unsigned char* vb_ = lds + VBASE + vs_cur * VSTG + vfrag; const LAS unsigned char* kb_ = lds; bf16x8 fa[NM];
#pragma unroll
      for (int i = 0; i < PF; ++i) { A3_LOADF(i); fan[i] = fa[i]; } }
    if (wid >= 4) __builtin_amdgcn_s_setprio(1);
    int t = t0;
    for (; t + 1 < t1; t += 2) {
        A3_BODY(t, s0, s1, n0, n1);
        A3_BODY(t + 1, n0, n1, s0, s1);
    }
    if (t < t1) { A3_BODY(t, s0, s1, n0, n1); }
#undef A3_BODY
#undef A3_LOADF
#undef A4_BIAS
    if (__any(fprev != 1.0f)) {
#pragma unroll
        for (int d = 0; d < NDB; ++d)
#pragma unroll
            for (int r = 0; r < 16; ++r) o[d][r] *= fprev;
    }
    __builtin_amdgcn_s_setprio(0);
    A2_PV(vs_prev, pk);
    __syncthreads();
#undef A2_ISSUE_K
#undef A2_ISSUE_V
#undef A2_COMMIT_K
#undef A2_COMMIT_V
#undef A2_TILE_BIAS
#undef A2_QK
#undef A2_PV
    float lt = swapsum(lsum);
    if (MODE == 2) lt += __builtin_amdgcn_exp2f(A.sinks[2 * hx + st] * LOG2E - mref);
    const float inv = 1.0f / lt;
#pragma unroll
    for (int d = 0; d < NDB; ++d)
#pragma unroll
        for (int r = 0; r < 16; ++r) o[d][r] *= inv;
    const size_t orow = row0 + qslot0 + r32;
    if (MODE == 0) {
        LAS float* X = (LAS float*)lds;
        if (st == 1) {
#pragma unroll
            for (int d = 0; d < NDB; ++d)
#pragma unroll
                for (int r = 0; r < 16; ++r) X[(qg * 64 + d * 16 + r) * 64 + lane] = o[d][r];
        }
        __syncthreads();
        if (st == 0) {
            const float sx = wave_sum(A.dl[lane] * A.dl[64 + lane], lane), sy = wave_sum(A.dl[128 + lane] * A.dl[192 + lane], lane);
            const float lam = __expf(sx) - __expf(sy) + A.lam_init;
            float ss = 0.f;
#pragma unroll
            for (int d = 0; d < NDB; ++d)
#pragma unroll
                for (int r = 0; r < 16; ++r) { const float v = o[d][r] - lam * X[(qg * 64 + d * 16 + r) * 64 + lane]; o[d][r] = v; ss += v * v; }
            ss = swapsum(ss);
            const float rs = (1.0f / sqrtf(ss * (1.0f / 128.0f) + EPSN)) * (1.0f - A.lam_init);
            GAS bf16_t* op = (GAS bf16_t*)A.O + orow * DM + hx * 128 + 4 * hi;
#pragma unroll
            for (int d = 0; d < NDB; ++d)
#pragma unroll
                for (int g4 = 0; g4 < 4; ++g4) {
                    const f32x4 gv = *(const GAS f32x4*)((const GAS float*)A.gsub + d * 32 + 8 * g4 + 4 * hi);
                    u32x2 w; w.x = cvtpk(o[d][4 * g4] * rs * gv[0], o[d][4 * g4 + 1] * rs * gv[1]); w.y = cvtpk(o[d][4 * g4 + 2] * rs * gv[2], o[d][4 * g4 + 3] * rs * gv[3]);
                    *(GAS u32x2*)(op + d * 32 + 8 * g4) = w;
                }
        }
    } else {
        GAS bf16_t* op = (GAS bf16_t*)A.O + orow * DM + (MODE == 1 ? 768 : 512) + (2 * hx + st) * 64 + 4 * hi;
#pragma unroll
        for (int d = 0; d < NDB; ++d)
#pragma unroll
            for (int g4 = 0; g4 < 4; ++g4) {
                u32x2 w; w.x = cvtpk(o[d][4 * g4], o[d][4 * g4 + 1]); w.y = cvtpk(o[d][4 * g4 + 2], o[d][4 * g4 + 3]);
                *(GAS u32x2*)(op + d * 32 + 8 * g4) = w;
            }
    }
    __syncthreads();
}
__device__ __forceinline__ void norm_rows(float* LEAD, float* OUT, const float* gain, bf16_t* XN, int gw, int ngw) {
    int lane = threadIdx.x; asm volatile("" : "+v"(lane)); lane &= 63; asm volatile("" : "+s"(ngw), "+s"(gw));
    f32x4 g[4];
#pragma unroll
    for (int j = 0; j < 4; ++j) g[j] = ((const f32x4*)gain)[lane + 64 * j];
    for (int r = gw; r < MROWS; r += ngw) {
        const f32x4* hp = (const f32x4*)hrow(LEAD, OUT, r) + lane;
        f32x4 v[4]; float s = 0.f;
#pragma unroll
        for (int j = 0; j < 4; ++j) { v[j] = hp[64 * j]; s += (v[j].x * v[j].x + v[j].y * v[j].y) + (v[j].z * v[j].z + v[j].w * v[j].w); }
        const float rstd = 1.0f / sqrtf(wave_sum(s, lane) * (1.0f / DM) + EPSN);
        u32x2* o8 = (u32x2*)(XN + (size_t)r * DM) + lane;
#pragma unroll
        for (int j = 0; j < 4; ++j) { const f32x4 y = v[j] * rstd * g[j]; u32x2 w; w.x = pk2(y.x, y.y); w.y = pk2(y.z, y.w); o8[64 * j] = w; }
    }
}
__device__ __forceinline__ void final_rows(float* OUT, const float* gain, int gw, int ngw) {
    int lane = threadIdx.x; asm volatile("" : "+v"(lane)); lane &= 63; asm volatile("" : "+s"(ngw), "+s"(gw));
    f32x4 g[4];
#pragma unroll
    for (int j = 0; j < 4; ++j) g[j] = ((const f32x4*)gain)[lane + 64 * j];
    for (int r = gw; r < NSEQ * SEQ; r += ngw) {
        f32x4* hp = (f32x4*)(OUT + (size_t)r * DM) + lane;
        f32x4 v[4]; float s = 0.f;
#pragma unroll
        for (int j = 0; j < 4; ++j) { v[j] = hp[64 * j]; s += (v[j].x * v[j].x + v[j].y * v[j].y) + (v[j].z * v[j].z + v[j].w * v[j].w); }
        const float rstd = 1.0f / sqrtf(wave_sum(s, lane) * (1.0f / DM) + EPSN);
#pragma unroll
        for (int j = 0; j < 4; ++j) hp[64 * j] = v[j] * rstd * g[j];
    }
}
__device__ __forceinline__ void init_rows(const float* xp, const float* xs, const float* meta, float* LEAD, float* OUT, const float* gain, bf16_t* XN, float* SS, int gw, int ngw) {
    int lane = threadIdx.x; asm volatile("" : "+v"(lane)); lane &= 63; asm volatile("" : "+s"(ngw), "+s"(gw));
    f32x4 g[4];
#pragma unroll
    for (int j = 0; j < 4; ++j) g[j] = ((const f32x4*)gain)[lane + 64 * j];
    for (int r = gw; r < MROWS; r += ngw) {
        const int b = r / LP, s = r - b * LP;
        f32x4 v[4];
        if (s < 112) {
#pragma unroll
            for (int j = 0; j < 4; ++j) v[j] = (f32x4){0.f, 0.f, 0.f, 0.f};
        } else {
            const float* src = s < 128 ? meta + (size_t)(s - 112) * DM : (b < 2 ? xp + ((size_t)b * SEQ + (s - 128)) * DM : xs + ((size_t)(b - 2) * SEQ + (s - 128)) * DM);
#pragma unroll
            for (int j = 0; j < 4; ++j) v[j] = ((const f32x4*)src)[lane + 64 * j];
        }
        float sq = 0.f;
#pragma unroll
        for (int j = 0; j < 4; ++j) sq += (v[j].x * v[j].x + v[j].y * v[j].y) + (v[j].z * v[j].z + v[j].w * v[j].w);
        sq = wave_sum(sq, lane);
        if (lane == 0) SS[r] = sq;
        f32x4* hp = (f32x4*)hrow(LEAD, OUT, r) + lane;
        u32x2* o8 = (u32x2*)(XN + (size_t)r * DM) + lane;
#pragma unroll
        for (int j = 0; j < 4; ++j) { if (s < 128) hp[64 * j] = v[j]; const f32x4 y = v[j] * g[j]; u32x2 w; w.x = pk2(y.x, y.y); w.y = pk2(y.z, y.w); o8[64 * j] = w; }
    }
}
__device__ __forceinline__ void mla_rows(const bf16_t* U, const float* gcq, const float* gckv, const float* rope, bf16_t* XQ, bf16_t* XKV, bf16_t* KC, int gw, int ngw) {
    int lane = threadIdx.x; asm volatile("" : "+v"(lane)); lane &= 63; asm volatile("" : "+s"(ngw), "+s"(gw));
    const f32x4 gq = ((const f32x4*)gcq)[lane];
    const float gk0 = gckv[2 * lane], gk1 = gckv[2 * lane + 1];
    for (int r0 = gw; r0 < MROWS; r0 += 2 * ngw) {
        u32x2 cq[2]; unsigned ckv[2]; float krv[2], cs[2], sn[2]; int rr[2];
#pragma unroll
        for (int k = 0; k < 2; ++k) { int r = r0 + k * ngw; r = r < MROWS ? r : r0; rr[k] = r;
            const bf16_t* up = U + (size_t)r * DIN + 2048;
            cq[k] = *(const u32x2*)(up + 4 * lane); ckv[k] = *(const unsigned*)(up + 256 + 2 * lane); krv[k] = bf2f(up[384 + (lane & 31)]);
            const int s = r % LP, j = lane & 15; cs[k] = rope[(size_t)s * 32 + j]; sn[k] = rope[(size_t)s * 32 + 16 + j]; }
#pragma unroll
        for (int k = 0; k < 2; ++k) {
            if (k == 1 && r0 + ngw >= MROWS) break;
            const int r = rr[k];
            const float q0 = __builtin_bit_cast(float, cq[k].x << 16), q1 = __builtin_bit_cast(float, cq[k].x & 0xffff0000u), q2 = __builtin_bit_cast(float, cq[k].y << 16), q3 = __builtin_bit_cast(float, cq[k].y & 0xffff0000u);
            const float k0 = __builtin_bit_cast(float, ckv[k] << 16), k1 = __builtin_bit_cast(float, ckv[k] & 0xffff0000u);
            const float sq = wave_sum((q0 * q0 + q1 * q1) + (q2 * q2 + q3 * q3), lane), sk = wave_sum(k0 * k0 + k1 * k1, lane);
            const float rq = 1.0f / sqrtf(sq * (1.0f / 256.0f) + EPSN), rk = 1.0f / sqrtf(sk * (1.0f / 128.0f) + EPSN);
            u32x2 wq; wq.x = pk2(q0 * rq * gq.x, q1 * rq * gq.y); wq.y = pk2(q2 * rq * gq.z, q3 * rq * gq.w);
            *(u32x2*)(XQ + (size_t)r * 256 + 4 * lane) = wq;
            *(unsigned*)(XKV + (size_t)r * 128 + 2 * lane) = pk2(k0 * rk * gk0, k1 * rk * gk1);
            const float other = lane_xor(krv[k], lane, 16);
            const float ro = (lane & 16) ? (krv[k] * cs[k] + other * sn[k]) : (krv[k] * cs[k] - other * sn[k]);
            if (lane < 32) { const unsigned short ob = (unsigned short)f2bf(ro); bf16_t* kc = KC + (size_t)r * 384 + 64 + lane;
                kc[0] = ob; kc[96] = ob; kc[192] = ob; kc[288] = ob; }
        }
    }
}
#ifndef ATTN_FN
#define ATTN_FN attn_unit4
#endif
#ifndef REP_ATTN
#define REP_ATTN 1
#endif
#ifndef REP_GU
#define REP_GU 1
#endif
#define XB_TMO      128
#define XB_XCNT(j)  (256  + 64 * (j))
#define XB_XSUB(j)  (1280 + 64 * (j))
#define XB_XGEN(j)  (2304 + 64 * (j))
#define XB_TOP      3328
#define XB_TOPGEN   3392
#define XCD_BAR_WORDS 3456
#define XB_SPIN_CAP (1u << 18)

__device__ __forceinline__ unsigned xb_ld(unsigned* p)              { return __hip_atomic_load(p, __ATOMIC_RELAXED, __HIP_MEMORY_SCOPE_AGENT); }
__device__ __forceinline__ unsigned xb_add(unsigned* p, unsigned v) { return __hip_atomic_fetch_add(p, v, __ATOMIC_RELAXED, __HIP_MEMORY_SCOPE_AGENT); }
__device__ __forceinline__ unsigned xb_xcc_id() { return (unsigned)__builtin_amdgcn_s_getreg((3 << 11) | 20) & 0xFu; }
#define XB_SPIN(cond, bar) do { unsigned _sp = 0; while (cond) { __builtin_amdgcn_s_sleep(1); \
    if ((++_sp & 255u) == 0u) { if (xb_ld(&(bar)[XB_TMO])) break; if (_sp > XB_SPIN_CAP) { atomicAdd(&(bar)[XB_TMO], 1u); break; } } } } while (0)

struct XcdBarrier {
    unsigned* bar; unsigned x;
    volatile LAS unsigned* st;
};

__device__ __forceinline__ XcdBarrier xcd_barrier_post(unsigned* bar, volatile LAS unsigned* st) {
    XcdBarrier b; b.bar = bar; b.x = xb_xcc_id(); b.st = st;
    if (threadIdx.x == 0) (void)xb_add(&bar[XB_XCNT(b.x)], 1u);
    return b;
}
__device__ __forceinline__ void xcd_barrier_complete(unsigned* bar, unsigned x, unsigned& nloc, unsigned& nx) {
    const unsigned G = gridDim.x * gridDim.y * gridDim.z;
    unsigned sum, cnt, mine, sp = 0u;
    for (;;) {
        sum = 0u; cnt = 0u; mine = 0u;
#pragma unroll
        for (unsigned j = 0; j < 16; ++j) { const unsigned c = xb_ld(&bar[XB_XCNT(j)]); sum += c; cnt += (c > 0u) ? 1u : 0u; mine = (j == x) ? c : mine; }
        if (sum == G) break;
        __builtin_amdgcn_s_sleep(1);
        if ((++sp & 255u) == 0u) { if (xb_ld(&bar[XB_TMO])) break; if (sp > XB_SPIN_CAP) { atomicAdd(&bar[XB_TMO], 1u); break; } }
    }
    nloc = mine > 0u ? mine : 1u; nx = cnt > 0u ? cnt : 1u;
}

__device__ __forceinline__ void xcd_barrier(const XcdBarrier& b) {
    asm volatile("s_waitcnt vmcnt(0)" ::: "memory");
    __syncthreads();
    if (threadIdx.x == 0) {
        unsigned* bar = b.bar;
        __builtin_amdgcn_s_waitcnt(0);
        unsigned nloc = b.st[0], nx = b.st[1];
        if (nloc == 0u) { xcd_barrier_complete(bar, b.x, nloc, nx); b.st[0] = nloc; b.st[1] = nx; }
        const unsigned old = xb_add(&bar[XB_XSUB(b.x)], 1u);
        const unsigned gen = old / nloc;
        if (old + 1u == (gen + 1u) * nloc) {
            __builtin_amdgcn_fence(__ATOMIC_RELEASE, "agent");
            asm volatile("s_waitcnt vmcnt(0)" ::: "memory");
            const unsigned og = xb_add(&bar[XB_TOP], 1u);
            const unsigned tg = og / nx;
            if (og + 1u == (tg + 1u) * nx) xb_add(&bar[XB_TOPGEN], 1u);
            else XB_SPIN(xb_ld(&bar[XB_TOPGEN]) == tg, bar);
            __builtin_amdgcn_fence(__ATOMIC_ACQUIRE, "agent");
            xb_add(&bar[XB_XGEN(b.x)], 1u);
            asm volatile("s_waitcnt vmcnt(0)" ::: "memory");
        } else {
            XB_SPIN(xb_ld(&bar[XB_XGEN(b.x)]) == gen, bar);
            __builtin_amdgcn_fence(__ATOMIC_ACQUIRE, "agent");
            asm volatile("s_waitcnt vmcnt(0)" ::: "memory");
        }
    }
    __syncthreads();
}


constexpr int CW_BAR = 4096, CW_QUEUE = 64;
constexpr size_t CTL_ZERO_BYTES = 65536;
constexpr int MISC_OFF = 131072 + 320;
constexpr int I_GU = 16 * 176, I_D = 44 * 32, I_IN = 16 * 77, I_UQ = 4 * 12, I_UKV = 2 * 16, I_OUT = 16 * 32;
constexpr int I_LAYER = 2 * I_GU + 2 * I_D + I_IN + I_UQ + I_UKV + I_OUT;

struct KArgs { const float* in[21]; float* out; unsigned char* ws; float inv[16]; };

__global__ void __launch_bounds__(NTHR, 2) mega_fwd(KArgs a) {
    extern __shared__ __attribute__((aligned(16))) unsigned char lds_raw[];
    LAS unsigned char* lds = (LAS unsigned char*)lds_raw;
    cg::grid_group grid = cg::this_grid();
    const int wave = __builtin_amdgcn_readfirstlane(threadIdx.x >> 6);
    const int G = gridDim.x, bx = blockIdx.x;
    const int vcu = (G % 8 == 0) ? (bx % 8) * (G / 8) + bx / 8 : bx;
    const int gw = vcu * NWAVES + wave, ngw = G * NWAVES;
    unsigned char* const ws0 = a.ws;
    volatile LAS unsigned* MISC = (volatile LAS unsigned*)(lds + MISC_OFF);
    if (threadIdx.x < 32) MISC[threadIdx.x] = 0u;
    __syncthreads();
    (void)xcd_barrier_post((unsigned*)ws0 + CW_BAR, MISC + 8);
#define GRID_BAR() do { XcdBarrier xb_; xb_.bar = (unsigned*)ws0 + CW_BAR; xb_.x = xb_xcc_id(); xb_.st = (volatile LAS unsigned*)(lds + MISC_OFF) + 8; xcd_barrier(xb_); } while (0)

    {
        unsigned char* ws = ws0; float* LEAD = (float*)(ws + WS_LEAD); float* ROPE = (float*)(ws + WS_ROPE); float* OUT = a.out; bf16_t* XN = (bf16_t*)(ws + WS_XN);
        int tid = threadIdx.x; asm volatile("" : "+v"(tid)); const int lane = tid & 63;
        LAS float* scr = (LAS float*)(lds + wave * 16384);
#define CONVERT_ITEM(it_) do { const int it = (it_); \
            const int l = it / I_LAYER; int r = it - l * I_LAYER; \
            unsigned char* wl = ws + WS_W + (size_t)l * W_LAYER; \
            if (r < I_GU) { transpose_matrix_item<true>(a.in[5] + (size_t)l * 1024 * 5632, 1024, 5632, (bf16_t*)(wl + W_GU1), r, scr, lane); break; } r -= I_GU; \
            if (r < I_D) { transpose_matrix_item<false>(a.in[6] + (size_t)l * 2816 * 1024, 2816, 1024, (bf16_t*)(wl + W_D1), r, scr, lane); break; } r -= I_D; \
            if (r < I_IN) { transpose_matrix_item<false>(a.in[8] + (size_t)l * 1024 * DIN, 1024, DIN, (bf16_t*)(wl + W_IN), r, scr, lane); break; } r -= I_IN; \
            if (r < I_UQ) { transpose_matrix_item<false>(a.in[14] + (size_t)l * 256 * 384, 256, 384, (bf16_t*)(wl + W_UQ), r, scr, lane); break; } r -= I_UQ; \
            if (r < I_UKV) { transpose_matrix_item<false>(a.in[15] + (size_t)l * 128 * 512, 128, 512, (bf16_t*)(wl + W_UKV), r, scr, lane); break; } r -= I_UKV; \
            if (r < I_OUT) { transpose_matrix_item<false>(a.in[16] + (size_t)l * 1024 * 1024, 1024, 1024, (bf16_t*)(wl + W_OUT), r, scr, lane); break; } r -= I_OUT; \
            if (r < I_GU) { transpose_matrix_item<true>(a.in[18] + (size_t)l * 1024 * 5632, 1024, 5632, (bf16_t*)(wl + W_GU2), r, scr, lane); break; } r -= I_GU; \
            transpose_matrix_item<false>(a.in[19] + (size_t)l * 2816 * 1024, 2816, 1024, (bf16_t*)(wl + W_D2), r, scr, lane); \
         \
    } while (0)
        for (int it_ = gw; it_ < I_LAYER; it_ += ngw) CONVERT_ITEM(it_);
        const int gt = vcu * NTHR + tid, ngt = G * NTHR;
        for (int l = 0; l < 2; ++l) {
            u32x4* pin = (u32x4*)(ws + WS_W + (size_t)l * W_LAYER + W_IN + (size_t)DIN * 1024 * 2);
            for (int i = gt; i < 96 * 1024 * 2 / 16; i += ngt) pin[i] = (u32x4){0u, 0u, 0u, 0u};
            u32x4* puq = (u32x4*)(ws + WS_W + (size_t)l * W_LAYER + W_UQ + (size_t)384 * 256 * 2);
            for (int i = gt; i < 128 * 256 * 2 / 16; i += ngt) puq[i] = (u32x4){0u, 0u, 0u, 0u};
        }
        for (int i = gt; i < LP * 16; i += ngt) {
            const int s = i >> 4, j = i & 15;
            const float ang = (float)(s - 112) * a.inv[j];
            const double ad = (double)ang, kk = rint(ad * 0.15915494309189535);
            const float red = (float)(ad - kk * 6.283185307179586);
            ROPE[(size_t)s * 32 + j] = __cosf(red); ROPE[(size_t)s * 32 + 16 + j] = __sinf(red);
        }
        init_rows(a.in[0], a.in[1], a.in[2], LEAD, OUT, a.in[4], XN, (float*)(ws + WS_SS), gw, ngw);
    }
    if (a.ws == nullptr) grid.sync();
    GRID_BAR();

    int cons = 0;
#pragma unroll 1
    for (int i = 0; i < 4; ++i) {
        const int l = i >> 1;
        unsigned char* ws = ws0; asm volatile("" : "+s"(ws));
        float* LEAD = (float*)(ws + WS_LEAD); float* ROPE = (float*)(ws + WS_ROPE); float* OUT = a.out;
        bf16_t* XN = (bf16_t*)(ws + WS_XN); bf16_t* XQ = (bf16_t*)(ws + WS_XN + XQ_OFF); bf16_t* XKV = (bf16_t*)(ws + WS_XN + XKV_OFF);
        bf16_t* ACT = (bf16_t*)(ws + WS_BIG); bf16_t* U = (bf16_t*)(ws + WS_BIG + U_OFF); bf16_t* KC = (bf16_t*)(ws + WS_BIG + KC_OFF); bf16_t* VC = (bf16_t*)(ws + WS_BIG + VC_OFF);
        float* SSb = (float*)(ws + WS_SS);
        unsigned char* wl = ws + WS_W + (size_t)l * W_LAYER;
        {
            float* ssz = SSb + (size_t)((cons + 1) & 1) * MROWS; int t_ = threadIdx.x; asm volatile("" : "+v"(t_));
            { int st_ = G * NTHR; asm volatile("" : "+s"(st_)); float z_ = 0.f; asm volatile("" : "+v"(z_));
_Pragma("clang loop vectorize(disable) interleave(disable)")
              for (int r = vcu * NTHR + t_; r < MROWS; r += st_) ssz[r] = z_; }
            pg8::Gemm g{XN, (const bf16_t*)(wl + ((i & 1) ? W_GU2 : W_GU1)), MROWS, 5632, 1024}; pg8::StaticOrder S; S.init(MROWS, 5632, G, bx);
            pg8::EpiSwiGLU E{ACT, DFF, SSb + (size_t)(cons & 1) * MROWS};
            for (int rep_ = 0; rep_ < REP_GU; ++rep_) pg8::gemm_phase<pg8::EpiSwiGLU, pg8::StaticOrder, true, true>(lds, g, S, E);
        }
        GRID_BAR();
        {
            const float* gnext = (i & 1) ? ((i == 3) ? a.in[20] : a.in[4] + (size_t)(l + 1) * DM) : a.in[7] + (size_t)l * DM;
            pg8::Gemm g{ACT, (const bf16_t*)(wl + ((i & 1) ? W_D2 : W_D1)), MROWS, 1024, DFF}; pg8::StaticOrder S; S.init(MROWS, 1024, G, bx);
            pg8::EpiResid E{LEAD, OUT, 0.5f, XN, gnext, SSb + (size_t)((cons + 1) & 1) * MROWS, i == 0 ? a.in[0] : (const float*)nullptr, i == 0 ? a.in[1] : (const float*)nullptr};
            pg8::gemm_phase<pg8::EpiResid, pg8::StaticOrder, true, true>(lds, g, S, E);
        }
        if (i == 0 && bx >= 20) {
            int tid = threadIdx.x; asm volatile("" : "+v"(tid)); const int lane = tid & 63;
            LAS float* scr = (LAS float*)(lds + wave * 16384);
            for (int it_ = I_LAYER + (bx - 20) * NWAVES + wave; it_ < 2 * I_LAYER; it_ += (G - 20) * NWAVES) CONVERT_ITEM(it_);
        }
        ++cons;
        GRID_BAR();
        if (i == 3) { final_rows(OUT, a.in[20], gw, ngw); break; }
        if (i & 1) continue;
        {
            float* ssz = SSb + (size_t)((cons + 1) & 1) * MROWS; int t_ = threadIdx.x; asm volatile("" : "+v"(t_));
            { int st_ = G * NTHR; asm volatile("" : "+s"(st_)); float z_ = 0.f; asm volatile("" : "+v"(z_));
_Pragma("clang loop vectorize(disable) interleave(disable)")
              for (int r = vcu * NTHR + t_; r < MROWS; r += st_) ssz[r] = z_; }
            pg8::Gemm g{XN, (const bf16_t*)(wl + W_IN), MROWS, DINP, 1024}; pg8::StaticOrder S; S.init(MROWS, DINP, G, bx);
            pg8::EpiU E{U, 0.125f * LOG2E, SSb + (size_t)(cons & 1) * MROWS};
            pg8::gemm_phase<pg8::EpiU, pg8::StaticOrder, true, true>(lds, g, S, E);
        }
        GRID_BAR();
        mla_rows(U, a.in[12] + (size_t)l * 256, a.in[13] + (size_t)l * 128, ROPE, XQ, XKV, KC, gw, ngw);
        GRID_BAR();
        {
            int kq = 256; asm volatile("" : "+s"(kq));
            pg8::Gemm g{XQ, (const bf16_t*)(wl + W_UQ), MROWS, 512, kq}; pg8::StaticOrder S; S.init(MROWS, 512, G, bx);
            pg8::EpiQC E{U, ROPE, 0.10206207261596575f * LOG2E};
            pg8::gemm_phase<pg8::EpiQC, pg8::StaticOrder, true, true>(lds, g, S, E);
        }
        {
            int kkv = 128; asm volatile("" : "+s"(kkv));
            pg8::Gemm g{XKV, (const bf16_t*)(wl + W_UKV), MROWS, 512, kkv}; pg8::StaticOrder S; S.init(MROWS, 512, G, bx);
            pg8::EpiKV E{KC, VC};
            pg8::gemm_phase<pg8::EpiKV, pg8::StaticOrder, true, true>(lds, g, S, E);
        }
        GRID_BAR();
        {
            AttnArgs A{U, KC, VC, (bf16_t*)(ws + WS_O), a.in[3], a.in[9] + (size_t)l * 256, a.in[10] + (size_t)l * 128, a.in[11] + (size_t)l * 4, 0.8f - 0.6f * __expf(-0.3f * (float)l)};
            constexpr int NA = NSEQ * 4 * 65, NC = NSEQ * 2 * 65, NB = NSEQ * 2 * 65;
            unsigned* qhead = (unsigned*)ws + CW_QUEUE + 64 * l;
            for (;;) {
                if (threadIdx.x == 0) MISC[16] = atomicAdd(qhead, 1u);
                __syncthreads();
                const int u = (int)MISC[16];
                __syncthreads();
                if (u >= NA + NC + NB) break;
                if (l == 1 && (u % 65) == 0) continue;
                if (u < NA) ATTN_FN<0>(lds, u, A);
                else if (u < NA + NC) ATTN_FN<1>(lds, u - NA, A);
                else ATTN_FN<2>(lds, u - NA - NC, A);
            }
        }
        GRID_BAR();
        {
            pg8::Gemm g{(const bf16_t*)(ws + WS_O), (const bf16_t*)(wl + W_OUT), MROWS, 1024, 1024}; pg8::StaticOrder S; S.init(MROWS, 1024, G, bx);
            pg8::EpiResid E{LEAD, OUT, 1.0f, XN, a.in[17] + (size_t)l * DM, SSb + (size_t)((cons + 1) & 1) * MROWS, nullptr, nullptr};
            pg8::gemm_phase<pg8::EpiResid, pg8::StaticOrder, true, true>(lds, g, S, E);
        }
        ++cons;
        GRID_BAR();
    }
}

extern "C" void kernel_launch(void* const* d_in, const int* in_sizes, int n_in, void* d_out, int out_size, void* d_ws, size_t ws_size, hipStream_t stream) {
    static int grid = 0;
    if (grid == 0) {
        if (n_in != 21 || ws_size < WS_END) { fprintf(stderr, "kernel_launch: unexpected inputs (n_in %d, ws %zu, need %zu)\n", n_in, ws_size, (size_t)WS_END); grid = -1; return; }
        int dev = 0, cus = 0, per_cu = 0;
        hipGetDevice(&dev); hipDeviceGetAttribute(&cus, hipDeviceAttributeMultiprocessorCount, dev);
        if (hipFuncSetAttribute((const void*)mega_fwd, hipFuncAttributeMaxDynamicSharedMemorySize, LDS_BYTES) != hipSuccess) { fprintf(stderr, "kernel_launch: hipFuncSetAttribute failed\n"); grid = -1; return; }
        hipOccupancyMaxActiveBlocksPerMultiprocessor(&per_cu, (const void*)mega_fwd, NTHR, LDS_BYTES);
        (void)hipGetLastError();
        if (per_cu < 1) { fprintf(stderr, "kernel_launch: occupancy query says %d blocks per CU\n", per_cu); per_cu = 1; }
        grid = cus;
    }
    if (grid < 0) return;
    if (hipMemsetAsync(d_ws, 0, CTL_ZERO_BYTES, stream) != hipSuccess) { fprintf(stderr, "kernel_launch: memset failed\n"); return; }
    KArgs a{};
    for (int i = 0; i < 21; ++i) a.in[i] = (const float*)d_in[i];
    a.out = (float*)d_out; a.ws = (unsigned char*)d_ws;
    for (int j = 0; j < 16; ++j) a.inv[j] = (float)pow(10000.0, -(double)(2 * j) / 32.0);
    void* args[] = {&a};
    hipError_t e = hipLaunchCooperativeKernel((const void*)mega_fwd, dim3(grid), dim3(NTHR), args, LDS_BYTES, stream);
    if (e != hipSuccess) fprintf(stderr, "kernel_launch: cooperative launch failed: %s (grid %d)\n", hipGetErrorString(e), grid);
}
```

```cpp
#include <hip/hip_runtime.h>
#include <hip/hip_cooperative_groups.h>
#include <cstdio>
#include <cstdint>
namespace cg = cooperative_groups;
#define LAS __attribute__((address_space(3)))
#define GAS __attribute__((address_space(1)))
typedef unsigned short bf16_t;
typedef short bf16x8 __attribute__((ext_vector_type(8)));
typedef float f32x4 __attribute__((ext_vector_type(4)));
typedef float f32x16 __attribute__((ext_vector_type(16)));
typedef unsigned u32x4 __attribute__((ext_vector_type(4)));
typedef unsigned u32x2 __attribute__((ext_vector_type(2)));
typedef short v4i16_t __attribute__((ext_vector_type(4)));

constexpr int NSEQ = 10, LP = 8320, SEQ = 8192, DM = 1024, DFF = 2816, DIN = 2464, DINP = 2560;
constexpr int MROWS = NSEQ * LP;
constexpr int NTHR = 512, NWAVES = 8;
constexpr float LOG2E = 1.4426950408889634f;
constexpr float NEGBIG = -1.0e30f;
constexpr float EPSN = 1e-6f;

constexpr size_t MiB = 1u << 20;
constexpr size_t W_GU1 = 0, W_D1 = W_GU1 + (size_t)5632 * 1024 * 2, W_IN = W_D1 + (size_t)1024 * 2816 * 2, W_UQ = W_IN + (size_t)DINP * 1024 * 2,
                 W_UKV = W_UQ + (size_t)512 * 256 * 2, W_OUT = W_UKV + (size_t)512 * 128 * 2, W_GU2 = W_OUT + (size_t)1024 * 1024 * 2,
                 W_D2 = W_GU2 + (size_t)5632 * 1024 * 2, W_LAYER = W_D2 + (size_t)1024 * 2816 * 2;
static_assert(W_LAYER == 42336256, "weights per layer");
constexpr size_t WS_W = 1 * MiB, WS_LEAD = 82 * MiB, WS_ROPE = 87 * MiB, WS_XN = 89 * MiB, WS_BIG = 252 * MiB;
static_assert(WS_W + 2 * W_LAYER <= WS_LEAD, "ws map");
constexpr size_t WS_SS = 88 * MiB + 256 * 1024;
static_assert(WS_ROPE + (size_t)LP * 32 * 4 <= WS_SS && WS_SS + 2 * (size_t)MROWS * 4 <= WS_XN, "ss map");
constexpr size_t XQ_OFF = 0, XKV_OFF = (size_t)MROWS * 256 * 2;
constexpr size_t U_OFF = 0, KC_OFF = 392 * MiB, VC_OFF = (392 + 61) * MiB, BIG_END = 494 * MiB;
static_assert((size_t)MROWS * DIN * 2 <= KC_OFF && KC_OFF + (size_t)MROWS * 384 * 2 <= VC_OFF && VC_OFF + (size_t)MROWS * 256 * 2 <= BIG_END, "big map");
static_assert((size_t)MROWS * DFF * 2 <= BIG_END && WS_XN + (size_t)MROWS * DM * 2 <= WS_BIG, "big map 2");
constexpr size_t WS_O = WS_BIG + BIG_END;
constexpr size_t WS_END = WS_O + (size_t)MROWS * DM * 2;
static_assert(WS_END <= (size_t)1024 * MiB, "ws budget");

constexpr int LDS_BYTES = 147456;

__device__ __forceinline__ float lane_xor(float v, int lane, int o) { return __builtin_bit_cast(float, __builtin_amdgcn_ds_bpermute((lane ^ o) << 2, __builtin_bit_cast(int, v))); }
__device__ __forceinline__ float wave_sum(float v, int lane) {
#pragma unroll
    for (int o = 1; o < 64; o <<= 1) v += lane_xor(v, lane, o);
    return v;
}
__device__ __forceinline__ unsigned f2bf(float f) { unsigned u = __builtin_bit_cast(unsigned, f); return (u + 0x7fffu + ((u >> 16) & 1u)) >> 16; }
__device__ __forceinline__ unsigned pk2(float lo, float hi) { return f2bf(lo) | (f2bf(hi) << 16); }
__device__ __forceinline__ float bf2f(unsigned short b) { return __builtin_bit_cast(float, (unsigned)b << 16); }

struct Args { const float* in[21]; float* out; unsigned char* ws; };

__device__ __forceinline__ float* hrow(float* LEAD, float* OUT, int r) {
    const int b = r / LP, s = r - b * LP;
    return s < 128 ? LEAD + ((size_t)(b * 128 + s)) * DM : OUT + ((size_t)b * SEQ + (s - 128)) * DM;
}
namespace pg8 {
#define PG8_LAS __attribute__((address_space(3)))
typedef unsigned short bf16_t;
typedef short bf16x8 __attribute__((ext_vector_type(8)));
typedef float f32x4 __attribute__((ext_vector_type(4)));
typedef unsigned u32x4 __attribute__((ext_vector_type(4)));
constexpr int BM = 256, BK = 64, HALF = 128, HTB = HALF * BK * 2  , STAGE_BYTES = 8 * HTB, NXCD = 8, WGM = 8;

__host__ __device__ __forceinline__ int lds_byte(int r, int c) { const int st = (r >> 4) * 2 + (c >> 5), rr = r & 15, cc = c & 31, ob = rr * 64 + cc * 2; return st * 1024 + (ob ^ (((ob >> 9) & 1) << 5)); }
__host__ __device__ __forceinline__ void stage_rc(int b, int& R, int& C) { const int st = b / 1024, sb = b % 1024, swz = sb ^ (((sb >> 9) & 1) << 5); R = (st >> 1) * 16 + swz / 64; C = (st & 1) * 32 + (swz % 64) / 2; }
__host__ __device__ __forceinline__ int perm32(int rho) { const int n = rho >> 4, i = rho & 15; return 8 * (i >> 2) + 4 * n + (i & 3); }

struct Unit { int pm, pn; };
struct Gemm { const bf16_t* A; const bf16_t* Bt; int M, N, K; };

struct StaticOrder {
    int nM, nN, nwg, G, c;
    __host__ __device__ void init(int M, int N, int G_, int c_) { nM = M / BM; nN = N / BM; nwg = nM * nN; G = G_; c = c_; }
    __host__ __device__ bool next(int i, Unit& u) const {
        const long L = (long)i * G + c; if (L >= nwg) return false;
        int wgid = (int)L; { const int q = nwg / NXCD, r = nwg % NXCD, xcd = wgid % NXCD, off = wgid / NXCD; wgid = (xcd < r ? xcd * (q + 1) : r * (q + 1) + (xcd - r) * q) + off; }
        const int nig = WGM * nN, gid = wgid / nig, fm = gid * WGM, gsz = (nM - fm) < WGM ? (nM - fm) : WGM;
        u.pm = fm + ((wgid % nig) % gsz); u.pn = (wgid % nig) / gsz; return true;
    }
    __device__ __forceinline__ void a_ready(const Unit&) const {}
    __device__ __forceinline__ void done(const Unit&) const {}
};

__device__ __forceinline__ unsigned cvt_pk_bf16(float lo, float hi) { unsigned r; asm volatile("v_cvt_pk_bf16_f32 %0, %1, %2" : "=v"(r) : "v"(lo), "v"(hi)); return r; }
typedef float f32x2 __attribute__((ext_vector_type(2)));
__device__ __forceinline__ float silu_mul(float g, float u) { return g * __builtin_amdgcn_rcpf(1.0f + __builtin_amdgcn_exp2f(-g * 1.4426950408889634f)) * u; }
__device__ __forceinline__ f32x2 silu_mul2(f32x2 g, f32x2 u, float kneg, float rs2) {
    const f32x2 t = g * kneg;
    f32x2 e; e.x = __builtin_amdgcn_exp2f(t.x); e.y = __builtin_amdgcn_exp2f(t.y);
    const f32x2 d = e + 1.0f;
    f32x2 r; r.x = __builtin_amdgcn_rcpf(d.x); r.y = __builtin_amdgcn_rcpf(d.y);
    return (g * u) * (r * rs2);
}
struct EpiSwiGLU {
    static constexpr bool PERM = true, AFTER_DRAIN = false;
    bf16_t* O; int ldo; const float* SS;
    __device__ __forceinline__ void operator()(const f32x4 (&acc)[2][2][4][2], const Unit& u, int wr, int wc, int fr_in, int fq_in) const {
        int t_ = threadIdx.x; asm volatile("" : "+v"(t_)); const int fr = t_ & 15, fq = (t_ >> 4) & 3;
        const int row0 = u.pm * BM + wr * 64 + fr, col0 = u.pn * 128 + wc * 32 + 8 * fq;
        float ssv[2][4];
#pragma unroll
        for (int ai = 0; ai < 2; ++ai)
#pragma unroll
            for (int m = 0; m < 4; ++m) ssv[ai][m] = SS[row0 + ai * HALF + m * 16];
#pragma unroll
        for (int ai = 0; ai < 2; ++ai)
#pragma unroll
            for (int m = 0; m < 4; ++m) {
                const int row = row0 + ai * HALF + m * 16;
                const float rs = __builtin_amdgcn_rsqf(ssv[ai][m] * (1.0f / 1024.0f) + 1e-6f);
                const float kneg = -1.4426950408889634f * rs, rs2 = rs * rs;
                bf16_t* rowp = O + (size_t)row * ldo + col0;
                const f32x4 g0 = acc[ai][0][m][0], g1 = acc[ai][0][m][1], u0 = acc[ai][1][m][0], u1 = acc[ai][1][m][1];
                const f32x2 a0 = silu_mul2((f32x2){g0[0], g0[1]}, (f32x2){u0[0], u0[1]}, kneg, rs2), a1 = silu_mul2((f32x2){g0[2], g0[3]}, (f32x2){u0[2], u0[3]}, kneg, rs2);
                const f32x2 a2 = silu_mul2((f32x2){g1[0], g1[1]}, (f32x2){u1[0], u1[1]}, kneg, rs2), a3 = silu_mul2((f32x2){g1[2], g1[3]}, (f32x2){u1[2], u1[3]}, kneg, rs2);
                u32x4 w; w.x = cvt_pk_bf16(a0.x, a0.y); w.y = cvt_pk_bf16(a1.x, a1.y); w.z = cvt_pk_bf16(a2.x, a2.y); w.w = cvt_pk_bf16(a3.x, a3.y);
                *(u32x4*)rowp = w;
            }
    }
};
struct EpiResid {
    static constexpr bool PERM = true, AFTER_DRAIN = false;
    float* LEAD; float* OUT; float alpha; bf16_t* XN; const float* gain; float* SSout;
    const float* XP; const float* XS;
    __device__ __forceinline__ void operator()(const f32x4 (&acc)[2][2][4][2], const Unit& u, int wr, int wc, int fr_in, int fq_in) const {
        int t_ = threadIdx.x; asm volatile("" : "+v"(t_)); const int fr = t_ & 15, fq = (t_ >> 4) & 3, lane = t_ & 63;
        const int row0 = u.pm * BM + wr * 64 + fr, col0 = u.pn * BM + wc * 32 + 8 * fq;
        f32x4 gv[2][2];
#pragma unroll
        for (int bj = 0; bj < 2; ++bj) { gv[bj][0] = *(const f32x4*)(gain + col0 + bj * HALF); gv[bj][1] = *(const f32x4*)(gain + col0 + bj * HALF + 4); }
#pragma unroll
        for (int ai = 0; ai < 2; ++ai) {
            float* hp[4]; f32x4 hv[4][2][2];
#pragma unroll
            for (int m = 0; m < 4; ++m) { const int rw = row0 + ai * HALF + m * 16; hp[m] = hrow(LEAD, OUT, rw) + col0;
                const float* sp = hp[m];
                if (XP) { const int b = rw / LP, sl = rw - b * LP; if (sl >= 128) sp = (b < 2 ? XP + ((size_t)b * SEQ + (sl - 128)) * DM : XS + ((size_t)(b - 2) * SEQ + (sl - 128)) * DM) + col0; }
#pragma unroll
                for (int bj = 0; bj < 2; ++bj) { hv[m][bj][0] = *(const f32x4*)(sp + bj * HALF); hv[m][bj][1] = *(const f32x4*)(sp + bj * HALF + 4); } }
#pragma unroll
            for (int m = 0; m < 4; ++m) {
                const int row = row0 + ai * HALF + m * 16;
                bf16_t* xp = XN + (size_t)row * DM + col0;
                float sq = 0.f;
#pragma unroll
                for (int bj = 0; bj < 2; ++bj) {
                    const f32x4 a = hv[m][bj][0] + acc[ai][bj][m][0] * alpha, b = hv[m][bj][1] + acc[ai][bj][m][1] * alpha;
                    *(f32x4*)(hp[m] + bj * HALF) = a; *(f32x4*)(hp[m] + bj * HALF + 4) = b;
                    sq += (a[0] * a[0] + a[1] * a[1]) + (a[2] * a[2] + a[3] * a[3]) + (b[0] * b[0] + b[1] * b[1]) + (b[2] * b[2] + b[3] * b[3]);
                    const f32x4 xa = a * gv[bj][0], xb = b * gv[bj][1];
                    u32x4 w; w.x = cvt_pk_bf16(xa[0], xa[1]); w.y = cvt_pk_bf16(xa[2], xa[3]); w.z = cvt_pk_bf16(xb[0], xb[1]); w.w = cvt_pk_bf16(xb[2], xb[3]);
                    *(u32x4*)(xp + bj * HALF) = w;
                }
                sq += lane_xor(sq, lane, 16); sq += lane_xor(sq, lane, 32);
                if (fq == 0) atomicAdd(SSout + row, sq);
            }
        }
    }
};
struct EpiResidLast {
    static constexpr bool PERM = true, AFTER_DRAIN = false;
    float* LEAD; float* OUT; float alpha; bf16_t* XN; const float* gain; float* SSout;
    const float* XP; const float* XS;
    __device__ __forceinline__ void operator()(const f32x4 (&acc)[2][2][4][2], const Unit& u, int wr, int wc, int fr_in, int fq_in) const {
        int t_ = threadIdx.x; asm volatile("" : "+v"(t_)); const int fr = t_ & 15, fq = (t_ >> 4) & 3, lane = t_ & 63;
        const int row0 = u.pm * BM + wr * 64 + fr, col0 = u.pn * BM + wc * 32 + 8 * fq;
        f32x4 gv[2][2];
#pragma unroll
        for (int bj = 0; bj < 2; ++bj) { gv[bj][0] = *(const f32x4*)(gain + col0 + bj * HALF); gv[bj][1] = *(const f32x4*)(gain + col0 + bj * HALF + 4); }
#pragma unroll
        for (int ai = 0; ai < 2; ++ai) {
            float* hp[4]; f32x4 hv[4][2][2];
#pragma unroll
            for (int m = 0; m < 4; ++m) { const int rw = row0 + ai * HALF + m * 16; hp[m] = hrow(LEAD, OUT, rw) + col0;
                const float* sp = hp[m];
                if (XP) { const int b = rw / LP, sl = rw - b * LP; if (sl >= 128) sp = (b < 2 ? XP + ((size_t)b * SEQ + (sl - 128)) * DM : XS + ((size_t)(b - 2) * SEQ + (sl - 128)) * DM) + col0; }
#pragma unroll
                for (int bj = 0; bj < 2; ++bj) { hv[m][bj][0] = *(const f32x4*)(sp + bj * HALF); hv[m][bj][1] = *(const f32x4*)(sp + bj * HALF + 4); } }
#pragma unroll
            for (int m = 0; m < 4; ++m) {
                const int row = row0 + ai * HALF + m * 16;
                bf16_t* xp = XN + (size_t)row * DM + col0;
                float sq = 0.f;
#pragma unroll
                for (int bj = 0; bj < 2; ++bj) {
                    const f32x4 a = hv[m][bj][0] + acc[ai][bj][m][0] * alpha, b = hv[m][bj][1] + acc[ai][bj][m][1] * alpha;
                    *(f32x4*)(hp[m] + bj * HALF) = a; *(f32x4*)(hp[m] + bj * HALF + 4) = b;
                    sq += (a[0] * a[0] + a[1] * a[1]) + (a[2] * a[2] + a[3] * a[3]) + (b[0] * b[0] + b[1] * b[1]) + (b[2] * b[2] + b[3] * b[3]);
                }
            }
        }
    }
};
struct EpiU {
    static constexpr bool PERM = true, AFTER_DRAIN = false;
    bf16_t* U; float qs; const float* SS;
    __device__ __forceinline__ void operator()(const f32x4 (&acc)[2][2][4][2], const Unit& u, int wr, int wc, int fr_in, int fq_in) const {
        int t_ = threadIdx.x; asm volatile("" : "+v"(t_)); const int fr = t_ & 15, fq = (t_ >> 4) & 3;
        const int row0 = u.pm * BM + wr * 64 + fr, col0 = u.pn * BM + wc * 32 + 8 * fq;
        const float sc = (u.pn < 2 || u.pn == 6) ? qs : 1.0f;
        float ssv[2][4];
#pragma unroll
        for (int ai = 0; ai < 2; ++ai)
#pragma unroll
            for (int m = 0; m < 4; ++m) ssv[ai][m] = SS[row0 + ai * HALF + m * 16];
#pragma unroll
        for (int ai = 0; ai < 2; ++ai)
#pragma unroll
            for (int m = 0; m < 4; ++m) {
                const int row = row0 + ai * HALF + m * 16;
                const float rs = __builtin_amdgcn_rsqf(ssv[ai][m] * (1.0f / 1024.0f) + 1e-6f) * sc;
                bf16_t* rowp = U + (size_t)row * DIN + col0;
#pragma unroll
                for (int bj = 0; bj < 2; ++bj) {
                    if (col0 + bj * HALF < DIN) {
                        const f32x4 v0 = acc[ai][bj][m][0] * rs, v1 = acc[ai][bj][m][1] * rs;
                        u32x4 w; w.x = cvt_pk_bf16(v0[0], v0[1]); w.y = cvt_pk_bf16(v0[2], v0[3]); w.z = cvt_pk_bf16(v1[0], v1[1]); w.w = cvt_pk_bf16(v1[2], v1[3]);
                        *(u32x4*)(rowp + bj * HALF) = w;
                    }
                }
            }
    }
};
struct EpiQC {
    static constexpr bool PERM = false, AFTER_DRAIN = false;
    bf16_t* U; const float* rope; float qs;
    __device__ __forceinline__ void operator()(const f32x4 (&acc)[2][2][4][2], const Unit& u, int wr, int wc, int fr_in, int fq_in) const {
        int t_ = threadIdx.x; asm volatile("" : "+v"(t_)); const int fr = t_ & 15, fq = (t_ >> 4) & 3;
        const int row0 = u.pm * BM + wr * 64 + fr;
#pragma unroll
        for (int bj = 0; bj < 2; ++bj) {
            const int cg0 = u.pn * BM + bj * HALF + wc * 32;
            if (cg0 >= 384) continue;
            const bool isrope = ((cg0 >> 5) % 3) == 2;
#pragma unroll
            for (int ai = 0; ai < 2; ++ai)
#pragma unroll
                for (int m = 0; m < 4; ++m) {
                    const int r = row0 + ai * HALF + m * 16;
                    f32x4 x1 = acc[ai][bj][m][0] * qs, x2 = acc[ai][bj][m][1] * qs;
                    if (isrope) {
                        const int s = r % LP;
                        const f32x4 cs = *(const f32x4*)(rope + (size_t)s * 32 + 4 * fq), sn = *(const f32x4*)(rope + (size_t)s * 32 + 16 + 4 * fq);
                        const f32x4 o1 = x1 * cs - x2 * sn, o2 = x2 * cs + x1 * sn; x1 = o1; x2 = o2;
                    }
                    bf16_t* p = U + (size_t)r * DIN + 2048 + cg0 + 4 * fq;
                    u32x2 w1, w2; w1.x = cvt_pk_bf16(x1[0], x1[1]); w1.y = cvt_pk_bf16(x1[2], x1[3]); w2.x = cvt_pk_bf16(x2[0], x2[1]); w2.y = cvt_pk_bf16(x2[2], x2[3]);
                    *(u32x2*)p = w1; *(u32x2*)(p + 16) = w2;
                }
        }
    }
};
struct EpiKV {
    static constexpr bool PERM = true, AFTER_DRAIN = false;
    bf16_t* KC; bf16_t* VC;
    __device__ __forceinline__ void operator()(const f32x4 (&acc)[2][2][4][2], const Unit& u, int wr, int wc, int fr_in, int fq_in) const {
        int t_ = threadIdx.x; asm volatile("" : "+v"(t_)); const int fr = t_ & 15, fq = (t_ >> 4) & 3;
        const int row0 = u.pm * BM + wr * 64 + fr;
#pragma unroll
        for (int ai = 0; ai < 2; ++ai)
#pragma unroll
            for (int m = 0; m < 4; ++m) {
                const size_t r = (size_t)(row0 + ai * HALF + m * 16);
#pragma unroll
                for (int bj = 0; bj < 2; ++bj) {
                    const int hh = u.pn * 2 + bj;
                    const f32x4 v0 = acc[ai][bj][m][0], v1 = acc[ai][bj][m][1];
                    u32x4 w; w.x = cvt_pk_bf16(v0[0], v0[1]); w.y = cvt_pk_bf16(v0[2], v0[3]); w.z = cvt_pk_bf16(v1[0], v1[1]); w.w = cvt_pk_bf16(v1[2], v1[3]);
                    bf16_t* p = (wc < 2) ? KC + r * 384 + hh * 96 + wc * 32 + 8 * fq : VC + r * 256 + hh * 64 + (wc - 2) * 32 + 8 * fq;
                    *(u32x4*)p = w;
                }
            }
    }
};
template <class Epi, class Sched, bool ALIGN_EPI = false, bool SP2 = false>
__device__ __forceinline__ void gemm_phase(PG8_LAS unsigned char* lds, const Gemm g, const Sched& S, const Epi& E) {
    int tid_ = threadIdx.x; asm volatile("" : "+v"(tid_));
    const int tid = tid_, wid = __builtin_amdgcn_readfirstlane(tid >> 6), lane = tid & 63, wr = wid >> 2, wc = wid & 3, fr = lane & 15, fq = lane >> 4;
    const int K = g.K, nt = K / BK;
    unsigned voffA[2], voffB[2];
#pragma unroll
    for (int i = 0; i < 2; ++i) { int R, C; stage_rc(tid * 16 + i * 8192, R, C); const int Rb = Epi::PERM ? ((R & ~31) + perm32(R & 31)) : R;
        voffA[i] = (unsigned)(R * K + C) * 2u; voffB[i] = (unsigned)(Rb * K + C) * 2u; }
    const size_t kstep = (size_t)(BK * 2);
    const size_t hstep = (size_t)HALF * K * 2;
    const size_t tstep = 2 * hstep;
    const unsigned ldsw = (unsigned)wid * 1024u;
    const int aoff = lds_byte(wr * 64 + fr, fq * 8), boff = lds_byte(wc * 32 + fr, fq * 8);
#define PG8_SA(b, h) (((b) * 2 + (h)) * HTB)
#define PG8_SB(b, h) ((4 + (b) * 2 + (h)) * HTB)
#define PG8_STAGE(bufoff, gbase, voff) do { _Pragma("unroll") for (int _i = 0; _i < 2; ++_i) \
        __builtin_amdgcn_global_load_lds((const unsigned*)((const char*)(gbase) + (voff)[_i]), (PG8_LAS unsigned*)(lds + (bufoff) + ldsw + _i * 8192), 16, 0, 0); } while (0)
#define PG8_LDA(dst, b, h) do { _Pragma("unroll") for (int m = 0; m < 4; ++m) _Pragma("unroll") for (int k = 0; k < 2; ++k) dst[m][k] = *(const PG8_LAS bf16x8*)(lds + PG8_SA(b, h) + aoff + m * 2048 + k * 1024); } while (0)
#define PG8_LDB(dst, b, h) do { _Pragma("unroll") for (int n = 0; n < 2; ++n) _Pragma("unroll") for (int k = 0; k < 2; ++k) dst[n][k] = *(const PG8_LAS bf16x8*)(lds + PG8_SB(b, h) + boff + n * 2048 + k * 1024); } while (0)
#define PG8_MMA(ai, bj, At, Bt) do { __builtin_amdgcn_s_setprio(1); _Pragma("unroll") for (int m = 0; m < 4; ++m) _Pragma("unroll") for (int n = 0; n < 2; ++n) _Pragma("unroll") for (int k = 0; k < 2; ++k) \
        acc[ai][bj][m][n] = __builtin_amdgcn_mfma_f32_16x16x32_bf16(Bt[n][k], At[m][k], acc[ai][bj][m][n], 0, 0, 0); __builtin_amdgcn_s_setprio(0); } while (0)
#define PG8_WAIT_V(n) asm volatile("s_waitcnt vmcnt(" #n ")" ::: "memory")
#define PG8_WAIT_L(n) asm volatile("s_waitcnt lgkmcnt(" #n ")" ::: "memory")
#define PG8_BAR __builtin_amdgcn_s_barrier()
#define PG8_SCHED __builtin_amdgcn_sched_barrier(0)
    Unit cur, nxt; int ui = 0;
    if (!S.next(0, cur)) return;
    f32x4 acc[2][2][4][2];
#pragma unroll
    for (int a = 0; a < 2; ++a)
#pragma unroll
        for (int b = 0; b < 2; ++b)
#pragma unroll
            for (int m = 0; m < 4; ++m)
#pragma unroll
                for (int n = 0; n < 2; ++n) acc[a][b][m][n] = (f32x4){0.f, 0.f, 0.f, 0.f};
    bf16x8 At[4][2], B0[2][2], B1[2][2];
    const char* cA = (const char*)g.A + (size_t)cur.pm * tstep; const char* cB = (const char*)g.Bt + (size_t)cur.pn * tstep;
    S.a_ready(cur);
    if constexpr (SP2) {
        PG8_STAGE(PG8_SB(0, 0), cB, voffB); PG8_STAGE(PG8_SB(0, 1), cB + hstep, voffB); PG8_STAGE(PG8_SA(0, 0), cA, voffA); PG8_STAGE(PG8_SA(0, 1), cA + hstep, voffA);
        if (wr == 1) PG8_BAR;
        PG8_WAIT_V(2); PG8_BAR;
        PG8_STAGE(PG8_SB(1, 0), cB + kstep, voffB); PG8_STAGE(PG8_SA(1, 0), cA + kstep, voffA); PG8_STAGE(PG8_SB(1, 1), cB + hstep + kstep, voffB);
        PG8_WAIT_V(6); PG8_BAR;
    } else {
        PG8_STAGE(PG8_SB(0, 0), cB, voffB); PG8_STAGE(PG8_SA(0, 0), cA, voffA); PG8_STAGE(PG8_SB(0, 1), cB + hstep, voffB); PG8_STAGE(PG8_SA(0, 1), cA + hstep, voffA);
        if (wr == 1) PG8_BAR;
        PG8_WAIT_V(4); PG8_BAR;
        PG8_STAGE(PG8_SB(1, 0), cB + kstep, voffB); PG8_STAGE(PG8_SA(1, 0), cA + kstep, voffA); PG8_STAGE(PG8_SB(1, 1), cB + hstep + kstep, voffB);
        PG8_WAIT_V(6); PG8_BAR;
    }
    for (;;) {
        const bool has_next = S.next(ui + 1, nxt);
        const char* nA = has_next ? (const char*)g.A + (size_t)nxt.pm * tstep : cA; const char* nB = has_next ? (const char*)g.Bt + (size_t)nxt.pn * tstep : cB;
        for (int t = 0; t < nt; t += 2) {
            const bool last = (t == nt - 2);
            const char* a1 = cA + (size_t)(t + 1) * kstep;
            const char* a2 = last ? nA : cA + (size_t)(t + 2) * kstep; const char* b2 = last ? nB : cB + (size_t)(t + 2) * kstep;
            const char* a3 = a2 + kstep; const char* b3 = b2 + kstep;
            if (last && has_next) S.a_ready(nxt);
            if constexpr (SP2) {
            PG8_LDB(B0, 0, 0); PG8_LDB(B1, 0, 1); PG8_SCHED; PG8_LDA(At, 0, 0); PG8_STAGE(PG8_SA(1, 1), a1 + hstep, voffA);
            PG8_WAIT_V(8); PG8_WAIT_L(0); PG8_BAR; PG8_MMA(0, 0, At, B0); PG8_MMA(0, 1, At, B1); PG8_BAR; PG8_SCHED;
            PG8_LDA(At, 0, 1); PG8_STAGE(PG8_SB(0, 0), b2, voffB); PG8_STAGE(PG8_SB(0, 1), b2 + hstep, voffB); PG8_STAGE(PG8_SA(0, 0), a2, voffA);
            PG8_WAIT_V(8); PG8_WAIT_L(0); PG8_BAR; PG8_MMA(1, 0, At, B0); PG8_MMA(1, 1, At, B1); PG8_BAR; PG8_SCHED;
            PG8_LDB(B0, 1, 0); PG8_LDB(B1, 1, 1); PG8_SCHED; PG8_LDA(At, 1, 0); PG8_STAGE(PG8_SA(0, 1), a2 + hstep, voffA);
            PG8_WAIT_V(8); PG8_WAIT_L(0); PG8_BAR; PG8_MMA(0, 0, At, B0); PG8_MMA(0, 1, At, B1); PG8_BAR; PG8_SCHED;
            PG8_LDA(At, 1, 1); PG8_STAGE(PG8_SB(1, 0), b3, voffB); PG8_STAGE(PG8_SB(1, 1), b3 + hstep, voffB); PG8_STAGE(PG8_SA(1, 0), a3, voffA);
            PG8_WAIT_V(8); PG8_WAIT_L(0); PG8_BAR; PG8_MMA(1, 0, At, B0); PG8_MMA(1, 1, At, B1); PG8_BAR; PG8_SCHED;
            } else {
            PG8_LDB(B0, 0, 0); PG8_SCHED; PG8_LDA(At, 0, 0); PG8_STAGE(PG8_SA(1, 1), a1 + hstep, voffA);
            PG8_WAIT_L(8); PG8_BAR; PG8_WAIT_L(0); PG8_MMA(0, 0, At, B0); PG8_BAR; PG8_SCHED;
            PG8_LDB(B1, 0, 1); PG8_STAGE(PG8_SB(0, 0), b2, voffB);
            PG8_BAR; PG8_WAIT_L(0); PG8_MMA(0, 1, At, B1); PG8_BAR;
            PG8_LDA(At, 0, 1); PG8_STAGE(PG8_SA(0, 0), a2, voffA);
            PG8_BAR; PG8_WAIT_L(0); PG8_MMA(1, 0, At, B0); PG8_BAR; PG8_SCHED;
            PG8_STAGE(PG8_SB(0, 1), b2 + hstep, voffB);
            PG8_WAIT_V(6); PG8_BAR; PG8_MMA(1, 1, At, B1); PG8_BAR;
            PG8_LDB(B0, 1, 0); PG8_SCHED; PG8_LDA(At, 1, 0); PG8_STAGE(PG8_SA(0, 1), a2 + hstep, voffA);
            PG8_WAIT_L(8); PG8_BAR; PG8_WAIT_L(0); PG8_MMA(0, 0, At, B0); PG8_BAR; PG8_SCHED;
            PG8_LDB(B1, 1, 1); PG8_STAGE(PG8_SB(1, 0), b3, voffB);
            PG8_BAR; PG8_WAIT_L(0); PG8_MMA(0, 1, At, B1); PG8_BAR;
            PG8_LDA(At, 1, 1); PG8_STAGE(PG8_SA(1, 0), a3, voffA);
            PG8_BAR; PG8_WAIT_L(0); PG8_MMA(1, 0, At, B0); PG8_BAR; PG8_SCHED;
            PG8_STAGE(PG8_SB(1, 1), b3 + hstep, voffB);
            PG8_WAIT_V(6); PG8_BAR; PG8_MMA(1, 1, At, B1); PG8_BAR;
            }
        }
        if constexpr (ALIGN_EPI) { if (wr == 0) PG8_BAR; }
        if constexpr (!Epi::AFTER_DRAIN) { E(acc, cur, wr, wc, fr, fq); S.done(cur); }
        if (!has_next) break;
#pragma unroll
        for (int a = 0; a < 2; ++a)
#pragma unroll
            for (int b = 0; b < 2; ++b)
#pragma unroll
                for (int m = 0; m < 4; ++m)
#pragma unroll
                    for (int n = 0; n < 2; ++n) acc[a][b][m][n] = (f32x4){0.f, 0.f, 0.f, 0.f};
        cur = nxt; cA = nA; cB = nB; ++ui;
        if constexpr (ALIGN_EPI) { if (wr == 1) PG8_BAR; }
    }
    PG8_WAIT_V(0);
    if constexpr (!ALIGN_EPI) { if (wr == 0) PG8_BAR; }
    PG8_BAR;
    if constexpr (Epi::AFTER_DRAIN) { E.fused(acc, cur, wr, wc, fr, fq, lds, wid, lane); S.done(cur); }
#undef PG8_SA
#undef PG8_SB
#undef PG8_STAGE
#undef PG8_LDA
#undef PG8_LDB
#undef PG8_MMA
#undef PG8_WAIT_V
#undef PG8_WAIT_L
#undef PG8_BAR
#undef PG8_SCHED
}
}
__device__ __forceinline__ void transpose_item(const float* W, int K, int N, bf16_t* WT, int k0, int n0, int drow0, LAS float* scr, int lane) {
#pragma unroll 8
    for (int i = 0; i < 32; ++i) { const int kk = 2 * i + (lane >> 5); scr[kk * 33 + (lane & 31)] = W[(size_t)(k0 + kk) * N + n0 + (lane & 31)]; }
    asm volatile("s_waitcnt lgkmcnt(0)" ::: "memory");
    const int c = lane & 7;
#pragma unroll
    for (int j = 0; j < 4; ++j) { const int n = (lane >> 3) + 8 * j; const LAS float* s = scr + (8 * c) * 33 + n;
        u32x4 o; o.x = pk2(s[0 * 33], s[1 * 33]); o.y = pk2(s[2 * 33], s[3 * 33]); o.z = pk2(s[4 * 33], s[5 * 33]); o.w = pk2(s[6 * 33], s[7 * 33]);
        *(u32x4*)(WT + (size_t)(drow0 + n) * K + k0 + 8 * c) = o; }
    asm volatile("s_waitcnt lgkmcnt(0)" ::: "memory");
}
template <bool GU> __device__ __forceinline__ void transpose_matrix_item(const float* W, int K, int N, bf16_t* WT, int item, LAS float* scr, int lane) {
    const int nblk = N / 32, kb = item / nblk, nb = item % nblk, n0 = 32 * nb;
    int drow0 = n0;
    if (GU) { const int isu = n0 >= DFF ? 1 : 0, ff0 = n0 - isu * DFF; drow0 = 256 * (ff0 >> 7) + 128 * isu + (ff0 & 127); }
    transpose_item(W, K, N, WT, 64 * kb, n0, drow0, scr, lane);
}

__device__ __forceinline__ int t5_bucket_dev(int rel) {
    const int n = rel < 0 ? -rel : rel;
    int b = n < 8 ? n : n < 12 ? 8 : n < 16 ? 9 : n < 23 ? 10 : n < 32 ? 11 : n < 46 ? 12 : n < 64 ? 13 : n < 91 ? 14 : 15;
    return b + (rel > 0 ? 16 : 0);
}
struct AttnArgs { const bf16_t* U; const bf16_t* KC; const bf16_t* VC; bf16_t* O; const float* rel_bias; const float* dl; const float* gsub; const float* sinks; float lam_init; };

__device__ __forceinline__ float max3f(float a, float b, float c) { float r; asm("v_max3_f32 %0, %1, %2, %3" : "=v"(r) : "v"(a), "v"(b), "v"(c)); return r; }
__device__ __forceinline__ float swapmax(float m) { auto rr = __builtin_amdgcn_permlane32_swap(__float_as_uint(m), __float_as_uint(m), false, false); return fmaxf(__uint_as_float(rr[0]), __uint_as_float(rr[1])); }
__device__ __forceinline__ float swapsum(float m) { auto rr = __builtin_amdgcn_permlane32_swap(__float_as_uint(m), __float_as_uint(m), false, false); return __uint_as_float(rr[0]) + __uint_as_float(rr[1]); }
typedef float f32x2_t __attribute__((ext_vector_type(2))); typedef __bf16 bf16x2_t __attribute__((ext_vector_type(2)));
__device__ __forceinline__ unsigned cvtpk(float lo, float hi) { f32x2_t v = {lo, hi}; bf16x2_t b = __builtin_convertvector(v, bf16x2_t); return __builtin_bit_cast(unsigned, b); }

template <int MODE> __device__ __forceinline__ void attn_unit(LAS unsigned char* lds, const int uidx, const AttnArgs& A) {
    constexpr int DQK = MODE == 1 ? 96 : 64, DV = MODE == 0 ? 128 : 64;
    constexpr int KCH = MODE == 0 ? 16 : (MODE == 1 ? 24 : 8), VCH = MODE == 2 ? 8 : 16;
    constexpr int KSTR = KCH * 16 + 16, VSTR = 320;
    constexpr int KSOFF = MODE == 0 ? 128 : (MODE == 1 ? 192 : 0), VSOFF = MODE == 1 ? 128 : 0;
    constexpr int NKL = KCH * 64 / NTHR, NVL = VCH * 64 / NTHR;
    constexpr int KOFF = 0, VOFF = 25600, BUFB = 46080, TABOFF = 92160;
    constexpr int NKC = DQK / 16, NDB = DV / 32;
    int tid = threadIdx.x; asm volatile("" : "+v"(tid));
    const int lane = tid & 63, wid = __builtin_amdgcn_readfirstlane(tid >> 6), r32 = lane & 31, hi = lane >> 5, qg = wid & 3, st = wid >> 2;
    const int qb = uidx % 65, bh = uidx / 65;
    const int NH = MODE == 0 ? 4 : 2;
    const int b = bh / NH, hx = bh % NH;
    const size_t row0 = (size_t)b * LP;
    const bf16_t *Kg, *Vg, *Qg; int kld, vld;
    if (MODE == 0) { Kg = A.U + 512 + hx * 128; kld = DIN; Vg = A.U + 1024 + hx * 128; vld = DIN; Qg = A.U + hx * 128 + st * 64; }
    else if (MODE == 1) { Kg = A.KC + hx * 192; kld = 384; Vg = A.VC + hx * 128; vld = 256; Qg = A.U + 2048 + (2 * hx + st) * 96; }
    else { Kg = A.U + 1792 + hx * 64; kld = DIN; Vg = A.U + 1920 + hx * 64; vld = DIN; Qg = A.U + 1536 + (2 * hx + st) * 64; }
    int t0 = 1, t1 = 130;
    if (MODE == 2) { t0 = 2 * (qb - 1); if (t0 < 1) t0 = 1; t1 = 2 * (qb + 2); if (t1 > 130) t1 = 130; }
    LAS float* tab = (LAS float*)(lds + TABOFF);
    if (MODE != 1) {
        const int rel = tid - 256; const int bk = t5_bucket_dev(rel);
        if (MODE == 0) { tab[tid] = A.rel_bias[bk * 8 + hx] * LOG2E; }
        else { const bool okw = (rel <= 128 && rel >= -128);
            tab[tid] = okw ? A.rel_bias[bk * 8 + 4 + 2 * hx] * LOG2E : NEGBIG; tab[512 + tid] = okw ? A.rel_bias[bk * 8 + 4 + 2 * hx + 1] * LOG2E : NEGBIG; }
    }
    const int qslot0 = qb * 128 + qg * 32;
    bf16x8 qf[NKC];
    { const bf16_t* qp = Qg + (row0 + qslot0 + r32) * DIN + hi * 8;
#pragma unroll
      for (int kc = 0; kc < NKC; ++kc) qf[kc] = *(const bf16x8*)(qp + kc * 16); }
    int ksrc[NKL], kdst[NKL], vsrc[NVL], vdst[NVL];
#pragma unroll
    for (int i = 0; i < NKL; ++i) { const int id = tid + NTHR * i, key = id / KCH, ch = id % KCH; ksrc[i] = key * kld + ch * 8; kdst[i] = KOFF + key * KSTR + ch * 16; }
#pragma unroll
    for (int i = 0; i < NVL; ++i) { const int id = tid + NTHR * i, key = id / VCH, ch = id % VCH; vsrc[i] = key * vld + ch * 8; vdst[i] = VOFF + key * VSTR + ch * 16; }
    u32x4 kst[NKL], vst[NVL];
#define ATT_ISSUE(t) do { const bf16_t* kp_ = Kg + (row0 + 64 * (size_t)(t)) * kld; const bf16_t* vp_ = Vg + (row0 + 64 * (size_t)(t)) * vld; \
        _Pragma("unroll") for (int i = 0; i < NKL; ++i) kst[i] = *(const u32x4*)(kp_ + ksrc[i]); \
        _Pragma("unroll") for (int i = 0; i < NVL; ++i) vst[i] = *(const u32x4*)(vp_ + vsrc[i]); } while (0)
#define ATT_COMMIT(buf) do { LAS unsigned char* bb_ = lds + (buf) * BUFB; \
        _Pragma("unroll") for (int i = 0; i < NKL; ++i) *(LAS u32x4*)(bb_ + kdst[i]) = kst[i]; \
        _Pragma("unroll") for (int i = 0; i < NVL; ++i) *(LAS u32x4*)(bb_ + vdst[i]) = vst[i]; } while (0)
    f32x16 o[NDB];
#pragma unroll
    for (int d = 0; d < NDB; ++d)
#pragma unroll
        for (int r = 0; r < 16; ++r) o[d][r] = 0.f;
    float mref = NEGBIG, lsum = 0.f;
    const int kfrag = st * KSOFF + r32 * KSTR + hi * 16;
    const int vfrag = st * VSOFF + (4 * hi + ((lane & 15) >> 2)) * VSTR + ((lane >> 4) & 1) * 32 + (lane & 3) * 8;
    const LAS float* mytab = tab + (MODE == 2 ? st * 512 : 0);
    ATT_ISSUE(t0); ATT_COMMIT(0); __syncthreads();
    for (int t = t0; t < t1; ++t) {
        const int buf = (t - t0) & 1;
        if (t + 1 < t1) ATT_ISSUE(t + 1);
        const LAS unsigned char* kb = lds + buf * BUFB + KOFF + kfrag;
        const LAS unsigned char* vb = lds + buf * BUFB + VOFF + vfrag;
        const int ks = 64 * t;
        bool near = (MODE == 2); float cb = 0.f;
        if (MODE == 0) { const int maxrel = ks + 63 - qslot0, minrel = ks - (qslot0 + 31);
            if (maxrel <= -91) cb = mytab[0]; else if (minrel >= 91) cb = mytab[511]; else near = true; }
        f32x16 p0, p1;
#pragma unroll
        for (int r = 0; r < 16; ++r) { p0[r] = cb; p1[r] = cb; }
#pragma unroll
        for (int kc = 0; kc < NKC; ++kc) {
            const bf16x8 a0 = *(const LAS bf16x8*)(kb + kc * 32), a1 = *(const LAS bf16x8*)(kb + 32 * KSTR + kc * 32);
            p0 = __builtin_amdgcn_mfma_f32_32x32x16_bf16(a0, qf[kc], p0, 0, 0, 0);
            p1 = __builtin_amdgcn_mfma_f32_32x32x16_bf16(a1, qf[kc], p1, 0, 0, 0);
        }
        if (MODE != 1 && near) {
            const int relb = ks + 4 * hi - (qslot0 + r32) + 256;
#pragma unroll
            for (int r = 0; r < 16; ++r) { const int c = (r & 3) + 8 * (r >> 2);
                int i0 = relb + c, i1 = relb + c + 32; i0 = i0 < 0 ? 0 : (i0 > 511 ? 511 : i0); i1 = i1 < 0 ? 0 : (i1 > 511 ? 511 : i1);
                p0[r] += mytab[i0]; p1[r] += mytab[i1]; }
        }
        if (t == 1) {
#pragma unroll
            for (int r = 0; r < 16; ++r) { const int c = (r & 3) + 8 * (r >> 2) + 4 * hi; p0[r] = NEGBIG; if (c < 16) p1[r] = NEGBIG; }
        }
        float mx = fmaxf(p0[0], p1[0]);
#pragma unroll
        for (int r = 1; r < 16; ++r) mx = fmaxf(mx, fmaxf(p0[r], p1[r]));
        mx = swapmax(mx);
        if (__any(mx > mref + 8.0f)) {
            const float mn = fmaxf(mref, mx), f = __builtin_amdgcn_exp2f(mref - mn); mref = mn; lsum *= f;
#pragma unroll
            for (int d = 0; d < NDB; ++d)
#pragma unroll
                for (int r = 0; r < 16; ++r) o[d][r] *= f;
        }
        float ps = 0.f;
#pragma unroll
        for (int r = 0; r < 16; ++r) { p0[r] = __builtin_amdgcn_exp2f(p0[r] - mref); p1[r] = __builtin_amdgcn_exp2f(p1[r] - mref); ps += p0[r] + p1[r]; }
        lsum += ps;
        bf16x8 pk[4];
        { u32x4 w;
          w.x = cvtpk(p0[0], p0[1]); w.y = cvtpk(p0[2], p0[3]); w.z = cvtpk(p0[4], p0[5]); w.w = cvtpk(p0[6], p0[7]); pk[0] = __builtin_bit_cast(bf16x8, w);
          w.x = cvtpk(p0[8], p0[9]); w.y = cvtpk(p0[10], p0[11]); w.z = cvtpk(p0[12], p0[13]); w.w = cvtpk(p0[14], p0[15]); pk[1] = __builtin_bit_cast(bf16x8, w);
          w.x = cvtpk(p1[0], p1[1]); w.y = cvtpk(p1[2], p1[3]); w.z = cvtpk(p1[4], p1[5]); w.w = cvtpk(p1[6], p1[7]); pk[2] = __builtin_bit_cast(bf16x8, w);
          w.x = cvtpk(p1[8], p1[9]); w.y = cvtpk(p1[10], p1[11]); w.z = cvtpk(p1[12], p1[13]); w.w = cvtpk(p1[14], p1[15]); pk[3] = __builtin_bit_cast(bf16x8, w); }
#pragma unroll
        for (int d = 0; d < NDB; ++d)
#pragma unroll
            for (int c = 0; c < 4; ++c) {
                const v4i16_t lo = __builtin_amdgcn_ds_read_tr16_b64_v4i16((LAS v4i16_t*)(vb + c * 16 * VSTR + d * 64));
                const v4i16_t hh = __builtin_amdgcn_ds_read_tr16_b64_v4i16((LAS v4i16_t*)(vb + c * 16 * VSTR + 8 * VSTR + d * 64));
                const bf16x8 vf = (bf16x8){lo[0], lo[1], lo[2], lo[3], hh[0], hh[1], hh[2], hh[3]};
                o[d] = __builtin_amdgcn_mfma_f32_32x32x16_bf16(vf, pk[c], o[d], 0, 0, 0);
            }
        if (t + 1 < t1) ATT_COMMIT(buf ^ 1);
        __syncthreads();
    }
#undef ATT_ISSUE
#undef ATT_COMMIT
    float lt = swapsum(lsum);
    if (MODE == 2) lt += __builtin_amdgcn_exp2f(A.sinks[2 * hx + st] * LOG2E - mref);
    const float inv = 1.0f / lt;
#pragma unroll
    for (int d = 0; d < NDB; ++d)
#pragma unroll
        for (int r = 0; r < 16; ++r) o[d][r] *= inv;
    const size_t orow = row0 + qslot0 + r32;
    if (MODE == 0) {
        LAS float* X = (LAS float*)lds;
        if (st == 1) {
#pragma unroll
            for (int d = 0; d < NDB; ++d)
#pragma unroll
                for (int r = 0; r < 16; ++r) X[(qg * 64 + d * 16 + r) * 64 + lane] = o[d][r];
        }
        __syncthreads();
        if (st == 0) {
            const float sx = wave_sum(A.dl[lane] * A.dl[64 + lane], lane), sy = wave_sum(A.dl[128 + lane] * A.dl[192 + lane], lane);
            const float lam = __expf(sx) - __expf(sy) + A.lam_init;
            float ss = 0.f;
#pragma unroll
            for (int d = 0; d < NDB; ++d)
#pragma unroll
                for (int r = 0; r < 16; ++r) { const float v = o[d][r] - lam * X[(qg * 64 + d * 16 + r) * 64 + lane]; o[d][r] = v; ss += v * v; }
            ss = swapsum(ss);
            const float rs = (1.0f / sqrtf(ss * (1.0f / 128.0f) + EPSN)) * (1.0f - A.lam_init);
            bf16_t* op = A.O + orow * DM + hx * 128 + 4 * hi;
#pragma unroll
            for (int d = 0; d < NDB; ++d)
#pragma unroll
                for (int g4 = 0; g4 < 4; ++g4) {
                    const f32x4 gv = *(const f32x4*)(A.gsub + d * 32 + 8 * g4 + 4 * hi);
                    u32x2 w; w.x = cvtpk(o[d][4 * g4] * rs * gv[0], o[d][4 * g4 + 1] * rs * gv[1]); w.y = cvtpk(o[d][4 * g4 + 2] * rs * gv[2], o[d][4 * g4 + 3] * rs * gv[3]);
                    *(u32x2*)(op + d * 32 + 8 * g4) = w;
                }
        }
    } else {
        bf16_t* op = A.O + orow * DM + (MODE == 1 ? 768 : 512) + (2 * hx + st) * 64 + 4 * hi;
#pragma unroll
        for (int d = 0; d < NDB; ++d)
#pragma unroll
            for (int g4 = 0; g4 < 4; ++g4) {
                u32x2 w; w.x = cvtpk(o[d][4 * g4], o[d][4 * g4 + 1]); w.y = cvtpk(o[d][4 * g4 + 2], o[d][4 * g4 + 3]);
                *(u32x2*)(op + d * 32 + 8 * g4) = w;
            }
    }
    __syncthreads();
}
#ifndef ATT_PF
#define ATT_PF 4
#endif
template <int MODE> __device__ __forceinline__ void attn_unit4(LAS unsigned char* lds, const int uidx, const AttnArgs& A) {
    constexpr int DQK = MODE == 1 ? 96 : 64, DV = MODE == 0 ? 128 : 64;
    constexpr int KCH = MODE == 0 ? 16 : (MODE == 1 ? 24 : 8), VCH = MODE == 2 ? 8 : 16;
    constexpr int KSTR = KCH * 16 + 16, VSTR = 320;
    constexpr int KSOFF = MODE == 0 ? 128 : (MODE == 1 ? 192 : 0), VSOFF = MODE == 1 ? 128 : 0;
    constexpr int NKL = KCH * 64 / NTHR, NVL = VCH * 64 / NTHR;
    constexpr int KSTG = 25600, VBASE = 2 * KSTG, VSTG = 20480, TABOFF = VBASE + 3 * VSTG;
    constexpr int NKC = DQK / 16, NDB = DV / 32;
    int tid = threadIdx.x; asm volatile("" : "+v"(tid));
    float negbig = NEGBIG; asm volatile("" : "+v"(negbig));
    const int lane = tid & 63, wid = __builtin_amdgcn_readfirstlane(tid >> 6), r32 = lane & 31, hi = lane >> 5, qg = wid & 3, st = wid >> 2;
    const int qb = uidx % 65, bh = uidx / 65;
    const int NH = MODE == 0 ? 4 : 2;
    const int b = bh / NH, hx = bh % NH;
    const size_t row0 = (size_t)b * LP;
    const GAS bf16_t *Kg, *Vg, *Qg; int kld, vld;
    if (MODE == 0) { Kg = (const GAS bf16_t*)A.U + 512 + hx * 128; kld = DIN; Vg = (const GAS bf16_t*)A.U + 1024 + hx * 128; vld = DIN; Qg = (const GAS bf16_t*)A.U + hx * 128 + st * 64; }
    else if (MODE == 1) { Kg = (const GAS bf16_t*)A.KC + hx * 192; kld = 384; Vg = (const GAS bf16_t*)A.VC + hx * 128; vld = 256; Qg = (const GAS bf16_t*)A.U + 2048 + (2 * hx + st) * 96; }
    else { Kg = (const GAS bf16_t*)A.U + 1792 + hx * 64; kld = DIN; Vg = (const GAS bf16_t*)A.U + 1920 + hx * 64; vld = DIN; Qg = (const GAS bf16_t*)A.U + 1536 + (2 * hx + st) * 64; }
    int t0 = 1, t1 = 130;
    if (MODE == 2) { t0 = 2 * (qb - 1); if (t0 < 1) t0 = 1; t1 = 2 * (qb + 2); if (t1 > 130) t1 = 130; }
    LAS float* tab = (LAS float*)(lds + TABOFF);
    if (MODE != 1) {
        const int rel = tid - 256; const int bk = t5_bucket_dev(rel);
        if (MODE == 0) { tab[tid] = A.rel_bias[bk * 8 + hx] * LOG2E; }
        else { const bool okw = (rel <= 128 && rel >= -128);
            tab[tid] = okw ? A.rel_bias[bk * 8 + 4 + 2 * hx] * LOG2E : negbig; tab[512 + tid] = okw ? A.rel_bias[bk * 8 + 4 + 2 * hx + 1] * LOG2E : negbig; }
    }
    const int qslot0 = qb * 128 + qg * 32;
    bf16x8 qf[NKC];
    { const GAS bf16_t* qp = Qg + (row0 + qslot0 + r32) * DIN + hi * 8;
#pragma unroll
      for (int kc = 0; kc < NKC; ++kc) qf[kc] = *(const GAS bf16x8*)(qp + kc * 16); }
    int ksrc[NKL], kdst[NKL], vsrc[NVL], vdst[NVL];
#pragma unroll
    for (int i = 0; i < NKL; ++i) { const int id = tid + NTHR * i, key = id / KCH, ch = id % KCH; ksrc[i] = key * kld + ch * 8; kdst[i] = key * KSTR + ch * 16; }
#pragma unroll
    for (int i = 0; i < NVL; ++i) { const int id = tid + NTHR * i, key = id / VCH, ch = id % VCH; vsrc[i] = key * vld + ch * 8; vdst[i] = VBASE + key * VSTR + ch * 16; }
    u32x4 kst[NKL], vst[NVL];
#define A2_ISSUE_K(t) do { int tc_ = (t); tc_ = tc_ < t1 ? tc_ : t1 - 1; const GAS bf16_t* kp_ = Kg + (row0 + 64 * (size_t)tc_) * kld; \
        _Pragma("unroll") for (int i = 0; i < NKL; ++i) kst[i] = *(const GAS u32x4*)(kp_ + ksrc[i]); } while (0)
#define A2_ISSUE_V(t) do { int tc_ = (t); tc_ = tc_ < t1 ? tc_ : t1 - 1; const GAS bf16_t* vp_ = Vg + (row0 + 64 * (size_t)tc_) * vld; \
        _Pragma("unroll") for (int i = 0; i < NVL; ++i) vst[i] = *(const GAS u32x4*)(vp_ + vsrc[i]); } while (0)
#define A2_COMMIT_K(slot) do { LAS unsigned char* bb_ = lds + (slot) * KSTG; _Pragma("unroll") for (int i = 0; i < NKL; ++i) *(LAS u32x4*)(bb_ + kdst[i]) = kst[i]; } while (0)
#define A2_COMMIT_V(slot) do { LAS unsigned char* bb_ = lds + (slot) * VSTG; _Pragma("unroll") for (int i = 0; i < NVL; ++i) *(LAS u32x4*)(bb_ + vdst[i]) = vst[i]; } while (0)
#define A2_TILE_BIAS(t, cbv, nearv) do { cbv = 0.f; nearv = (MODE == 2); if (MODE == 0) { const int ks_ = 64 * (t); const int maxrel_ = ks_ + 63 - qslot0, minrel_ = ks_ - (qslot0 + 31); \
        const bool lf_ = maxrel_ <= -91, rt_ = minrel_ >= 91; cbv = lf_ ? tabL : (rt_ ? tabR : 0.f); nearv = !(lf_ || rt_); } } while (0)
#define A2_QK(S0, S1, slot, cbv) do { const LAS unsigned char* kb_ = lds + (slot) * KSTG + kfrag; \
        _Pragma("unroll") for (int r = 0; r < 16; ++r) { S0[r] = cbv; S1[r] = cbv; } \
        _Pragma("unroll") for (int kc = 0; kc < NKC; ++kc) { const bf16x8 a0_ = *(const LAS bf16x8*)(kb_ + kc * 32), a1_ = *(const LAS bf16x8*)(kb_ + 32 * KSTR + kc * 32); \
            S0 = __builtin_amdgcn_mfma_f32_32x32x16_bf16(a0_, qf[kc], S0, 0, 0, 0); S1 = __builtin_amdgcn_mfma_f32_32x32x16_bf16(a1_, qf[kc], S1, 0, 0, 0); } } while (0)
#define A2_PV(slot, PK) do { const LAS unsigned char* vb_ = lds + VBASE + (slot) * VSTG + vfrag; \
        _Pragma("unroll") for (int d = 0; d < NDB; ++d) _Pragma("unroll") for (int c = 0; c < 4; ++c) { \
            const v4i16_t lo_ = __builtin_amdgcn_ds_read_tr16_b64_v4i16((LAS v4i16_t*)(vb_ + c * 16 * VSTR + d * 64)); \
            const v4i16_t hh_ = __builtin_amdgcn_ds_read_tr16_b64_v4i16((LAS v4i16_t*)(vb_ + c * 16 * VSTR + 8 * VSTR + d * 64)); \
            const bf16x8 vf_ = (bf16x8){lo_[0], lo_[1], lo_[2], lo_[3], hh_[0], hh_[1], hh_[2], hh_[3]}; \
            o[d] = __builtin_amdgcn_mfma_f32_32x32x16_bf16(vf_, __builtin_bit_cast(bf16x8, PK[c]), o[d], 0, 0, 0); } } while (0)
    f32x16 o[NDB];
#pragma unroll
    for (int d = 0; d < NDB; ++d)
#pragma unroll
        for (int r = 0; r < 16; ++r) o[d][r] = 0.f;
    float lsum = 0.f;
    const int kfrag = st * KSOFF + r32 * KSTR + hi * 16;
    const int vfrag = st * VSOFF + (4 * hi + ((lane & 15) >> 2)) * VSTR + ((lane >> 4) & 1) * 32 + (lane & 3) * 8;
    const LAS float* mytab = tab + (MODE == 2 ? st * 512 : 0);
    {
      u32x4 kst2[NKL];
      A2_ISSUE_K(t0); A2_ISSUE_V(t0);
      { const GAS bf16_t* kp_ = Kg + (row0 + 64 * (size_t)(t0 + 1)) * kld;
#pragma unroll
        for (int i = 0; i < NKL; ++i) kst2[i] = *(const GAS u32x4*)(kp_ + ksrc[i]); }
      A2_COMMIT_K(t0 & 1); A2_COMMIT_V(0);
      { LAS unsigned char* bb_ = lds + ((t0 + 1) & 1) * KSTG;
#pragma unroll
        for (int i = 0; i < NKL; ++i) *(LAS u32x4*)(bb_ + kdst[i]) = kst2[i]; } }
    __syncthreads();
    float tabL = 0.f, tabR = 0.f; if (MODE == 0) { tabL = mytab[0]; tabR = mytab[511]; }
    f32x16 s0, s1, n0, n1; u32x4 pk[4]; float fprev = 1.0f, fcur = 1.0f;
#define A4_BIAS(t, SA, SB) do { \
        const int relb = 64 * (t) + 4 * hi - (qslot0 + r32) + 256; \
        _Pragma("unroll") for (int r = 0; r < 16; ++r) { const int c = (r & 3) + 8 * (r >> 2); \
            int i0 = relb + c, i1 = relb + c + 32; i0 = i0 < 0 ? 0 : (i0 > 511 ? 511 : i0); i1 = i1 < 0 ? 0 : (i1 > 511 ? 511 : i1); \
            SA[r] += mytab[i0]; SB[r] += mytab[i1]; } } while (0)
    float cbc; bool nearc;
    A2_TILE_BIAS(t0, cbc, nearc);
    { const float zero_ = 0.f; A2_QK(s0, s1, t0 & 1, zero_); }
    __syncthreads();
    if (MODE != 1 && nearc) A4_BIAS(t0, s0, s1);
    if (t0 == 1) {
#pragma unroll
        for (int r = 0; r < 16; ++r) { const int c = (r & 3) + 8 * (r >> 2) + 4 * hi; s0[r] = negbig; if (c < 16) s1[r] = negbig; }
    }
    float mref;
    { float mx = fmaxf(s0[0], s1[0]);
#pragma unroll
      for (int r = 1; r < 16; ++r) mx = fmaxf(mx, fmaxf(s0[r], s1[r]));
      mx = swapmax(mx) + cbc; mref = fmaxf(mx, -30.0f);
      const float sh = cbc - mref;
#pragma unroll
      for (int r = 0; r < 16; ++r) { s0[r] += sh; s1[r] += sh; } }
    constexpr bool USE_NEGC = (MODE != 0);
    f32x16 negc;
    { float cb1; bool nr1; A2_TILE_BIAS(t0 + 1, cb1, nr1); const float nv = cb1 - mref;
#pragma unroll
      for (int r = 0; r < 16; ++r) { n0[r] = nv; n1[r] = nv; negc[r] = nv; } }
    int vs_prev = 2, vs_cur = 0, vs_next = 1;
#pragma unroll
    for (int c = 0; c < 4; ++c) pk[c] = (u32x4){0u, 0u, 0u, 0u};
    bf16x8 fan[ATT_PF];
    constexpr int NM = 2 * NKC + 4 * NDB;
    constexpr int EPS = (MODE == 2) ? 4 : 2;
    constexpr int PF = ATT_PF;
    constexpr int NPV = 4 * NDB;
    constexpr int GE = 8 / EPS;
    constexpr int GSTEP = GE > NDB ? GE : NDB;
    constexpr int GF = (MODE == 0) ? 4 : 2;
    static_assert(PF <= NPV, "prefetch");
#define A3_LOADF(i) do { if ((i) >= NPV) { const int j_ = (i) - NPV; fa[(i)] = *(const LAS bf16x8*)(kb_ + (j_ & 1) * 32 * KSTR + (j_ >> 1) * 32); } \
            else { const int c_ = (i) / NDB, d_ = (i) % NDB; \
                const v4i16_t lo_ = __builtin_amdgcn_ds_read_tr16_b64_v4i16((LAS v4i16_t*)(vb_ + c_ * 16 * VSTR + d_ * 64)); \
                const v4i16_t hh_ = __builtin_amdgcn_ds_read_tr16_b64_v4i16((LAS v4i16_t*)(vb_ + c_ * 16 * VSTR + 8 * VSTR + d_ * 64)); \
                fa[(i)] = (bf16x8){lo_[0], lo_[1], lo_[2], lo_[3], hh_[0], hh_[1], hh_[2], hh_[3]}; } } while (0)
#define A3_BODY(t, SC0, SC1, SN0, SN1) do { \
        if (__any(fprev != 1.0f)) { \
            _Pragma("unroll") for (int d = 0; d < NDB; ++d) _Pragma("unroll") for (int r = 0; r < 16; ++r) o[d][r] *= fprev; } \
        float cb1_, cb2_; bool nr1_, nr2_; \
        A2_TILE_BIAS((t) + 1, cb1_, nr1_); A2_TILE_BIAS((t) + 2, cb2_, nr2_); \
        const float nvn_ = cb2_ - mref;                         \
        const LAS unsigned char* kb_ = lds + (((t) + 1) & 1) * KSTG + kfrag; \
        const LAS unsigned char* vb_ = lds + VBASE + (((t) > t0) ? vs_prev : vs_cur) * VSTG + vfrag; \
        bf16x8 fa[NM]; \
        _Pragma("unroll") for (int i = 0; i < PF; ++i) fa[i] = fan[i]; \
        float ps = 0.f, eprev = 0.f; \
        __builtin_amdgcn_sched_barrier(0); \
        _Pragma("unroll") for (int i = 0; i < NM; ++i) { \
            if (i + PF < NM) A3_LOADF(i + PF); \
            if (i < NPV) { const int c = i / NDB, d = i % NDB; o[d] = __builtin_amdgcn_mfma_f32_32x32x16_bf16(fa[i], __builtin_bit_cast(bf16x8, pk[c]), o[d], 0, 0, 0); } \
            else { const int j = i - NPV; if (j & 1) SN1 = __builtin_amdgcn_mfma_f32_32x32x16_bf16(fa[i], qf[j >> 1], (USE_NEGC && j == 1) ? negc : SN1, 0, 0, 0); \
                                          else SN0 = __builtin_amdgcn_mfma_f32_32x32x16_bf16(fa[i], qf[j >> 1], (USE_NEGC && j == 0) ? negc : SN0, 0, 0, 0); } \
            _Pragma("unroll") for (int e = 0; e < 32; ++e) { \
                if (NDB + (e * (NM - NDB)) / 32 == i) { \
                    const float ev = __builtin_amdgcn_exp2f(e < 16 ? SC0[e & 15] : SC1[e & 15]); ps += ev; \
                    if (e & 1) pk[e >> 3][(e >> 1) & 3] = cvtpk(eprev, ev); else eprev = ev; } } \
            if (i == 1) A2_ISSUE_K((t) + 2); \
            if (i == 2) A2_ISSUE_V((t) + 1); \
            if (i == NM - 4) A2_COMMIT_K((t) & 1); \
            if (i == NM - 2) A2_COMMIT_V(vs_next); \
            __builtin_amdgcn_sched_barrier(0); \
        } \
        asm volatile("" :: "v"(pk[0]), "v"(pk[1]), "v"(pk[2]), "v"(pk[3]), "v"(ps)); \
        if (!USE_NEGC) { _Pragma("unroll") for (int r = 0; r < 16; ++r) { SC0[r] = nvn_; SC1[r] = nvn_; } } \
        { const LAS unsigned char* vbn_ = lds + VBASE + vs_cur * VSTG + vfrag;        \
          _Pragma("unroll") for (int i = 0; i < PF; ++i) { const int c_ = i / NDB, d_ = i % NDB; \
            const v4i16_t lo_ = __builtin_amdgcn_ds_read_tr16_b64_v4i16((LAS v4i16_t*)(vbn_ + c_ * 16 * VSTR + d_ * 64)); \
            const v4i16_t hh_ = __builtin_amdgcn_ds_read_tr16_b64_v4i16((LAS v4i16_t*)(vbn_ + c_ * 16 * VSTR + 8 * VSTR + d_ * 64)); \
            fan[i] = (bf16x8){lo_[0], lo_[1], lo_[2], lo_[3], hh_[0], hh_[1], hh_[2], hh_[3]}; } } \
        lsum = lsum * fcur + ps; \
        fprev = fcur; fcur = 1.0f; \
          \
        if (MODE != 1 && nr1_) A4_BIAS((t) + 1, SN0, SN1); \
        if ((t) + 1 < t1 && __any(ps > 1.0e12f)) { float dl = ps > 1.0e12f ? floorf(__builtin_amdgcn_logf(ps)) : 0.f; dl = swapmax(dl); \
            mref += dl; fcur = __builtin_amdgcn_exp2f(-dl); const float nv2_ = cb2_ - mref; \
            _Pragma("unroll") for (int r = 0; r < 16; ++r) { SN0[r] -= dl; SN1[r] -= dl; SC0[r] = nv2_; SC1[r] = nv2_; negc[r] = nv2_; } } \
        __syncthreads(); \
        { const int tmp = vs_prev; vs_prev = vs_cur; vs_cur = vs_next; vs_next = tmp; } \
    } while (0)
    { const LAS unsigned char* vb_ = lds + VBASE + vs_cur * VSTG + vfrag; const LAS unsigned char* kb_ = lds; bf16x8 fa[NM];
#pragma unroll
      for (int i = 0; i < PF; ++i) { A3_LOADF(i); fan[i] = fa[i]; } }
    if (wid >= 4) __builtin_amdgcn_s_setprio(1);
    int t = t0;
    for (; t + 1 < t1; t += 2) {
        A3_BODY(t, s0, s1, n0, n1);
        A3_BODY(t + 1, n0, n1, s0, s1);
    }
    if (t < t1) { A3_BODY(t, s0, s1, n0, n1); }
#undef A3_BODY
#undef A3_LOADF
#undef A4_BIAS
    if (__any(fprev != 1.0f)) {
#pragma unroll
        for (int d = 0; d < NDB; ++d)
#pragma unroll
            for (int r = 0; r < 16; ++r) o[d][r] *= fprev;
    }
    __builtin_amdgcn_s_setprio(0);
    A2_PV(vs_prev, pk);
    __syncthreads();
#undef A2_ISSUE_K
#undef A2_ISSUE_V
#undef A2_COMMIT_K
#undef A2_COMMIT_V
#undef A2_TILE_BIAS
#undef A2_QK
#undef A2_PV
    float lt = swapsum(lsum);
    if (MODE == 2) lt += __builtin_amdgcn_exp2f(A.sinks[2 * hx + st] * LOG2E - mref);
    const float inv = 1.0f / lt;
#pragma unroll
    for (int d = 0; d < NDB; ++d)
#pragma unroll
        for (int r = 0; r < 16; ++r) o[d][r] *= inv;
    const size_t orow = row0 + qslot0 + r32;
    if (MODE == 0) {
        LAS float* X = (LAS float*)lds;
        if (st == 1) {
#pragma unroll
            for (int d = 0; d < NDB; ++d)
#pragma unroll
                for (int r = 0; r < 16; ++r) X[(qg * 64 + d * 16 + r) * 64 + lane] = o[d][r];
        }
        __syncthreads();
        if (st == 0) {
            const float sx = wave_sum(A.dl[lane] * A.dl[64 + lane], lane), sy = wave_sum(A.dl[128 + lane] * A.dl[192 + lane], lane);
            const float lam = __expf(sx) - __expf(sy) + A.lam_init;
            float ss = 0.f;
#pragma unroll
            for (int d = 0; d < NDB; ++d)
#pragma unroll
                for (int r = 0; r < 16; ++r) { const float v = o[d][r] - lam * X[(qg * 64 + d * 16 + r) * 64 + lane]; o[d][r] = v; ss += v * v; }
            ss = swapsum(ss);
            const float rs = (1.0f / sqrtf(ss * (1.0f / 128.0f) + EPSN)) * (1.0f - A.lam_init);
            GAS bf16_t* op = (GAS bf16_t*)A.O + orow * DM + hx * 128 + 4 * hi;
#pragma unroll
            for (int d = 0; d < NDB; ++d)
#pragma unroll
                for (int g4 = 0; g4 < 4; ++g4) {
                    const f32x4 gv = *(const GAS f32x4*)((const GAS float*)A.gsub + d * 32 + 8 * g4 + 4 * hi);
                    u32x2 w; w.x = cvtpk(o[d][4 * g4] * rs * gv[0], o[d][4 * g4 + 1] * rs * gv[1]); w.y = cvtpk(o[d][4 * g4 + 2] * rs * gv[2], o[d][4 * g4 + 3] * rs * gv[3]);
                    *(GAS u32x2*)(op + d * 32 + 8 * g4) = w;
                }
        }
    } else {
        GAS bf16_t* op = (GAS bf16_t*)A.O + orow * DM + (MODE == 1 ? 768 : 512) + (2 * hx + st) * 64 + 4 * hi;
#pragma unroll
        for (int d = 0; d < NDB; ++d)
#pragma unroll
            for (int g4 = 0; g4 < 4; ++g4) {
                u32x2 w; w.x = cvtpk(o[d][4 * g4], o[d][4 * g4 + 1]); w.y = cvtpk(o[d][4 * g4 + 2], o[d][4 * g4 + 3]);
                *(GAS u32x2*)(op + d * 32 + 8 * g4) = w;
            }
    }
    __syncthreads();
}
__device__ __forceinline__ void norm_rows(float* LEAD, float* OUT, const float* gain, bf16_t* XN, int gw, int ngw) {
    int lane = threadIdx.x; asm volatile("" : "+v"(lane)); lane &= 63; asm volatile("" : "+s"(ngw), "+s"(gw));
    f32x4 g[4];
#pragma unroll
    for (int j = 0; j < 4; ++j) g[j] = ((const f32x4*)gain)[lane + 64 * j];
    for (int r = gw; r < MROWS; r += ngw) {
        const f32x4* hp = (const f32x4*)hrow(LEAD, OUT, r) + lane;
        f32x4 v[4]; float s = 0.f;
#pragma unroll
        for (int j = 0; j < 4; ++j) { v[j] = hp[64 * j]; s += (v[j].x * v[j].x + v[j].y * v[j].y) + (v[j].z * v[j].z + v[j].w * v[j].w); }
        const float rstd = 1.0f / sqrtf(wave_sum(s, lane) * (1.0f / DM) + EPSN);
        u32x2* o8 = (u32x2*)(XN + (size_t)r * DM) + lane;
#pragma unroll
        for (int j = 0; j < 4; ++j) { const f32x4 y = v[j] * rstd * g[j]; u32x2 w; w.x = pk2(y.x, y.y); w.y = pk2(y.z, y.w); o8[64 * j] = w; }
    }
}
__device__ __forceinline__ void final_rows(float* OUT, const float* gain, int gw, int ngw) {
    int lane = threadIdx.x; asm volatile("" : "+v"(lane)); lane &= 63; asm volatile("" : "+s"(ngw), "+s"(gw));
    f32x4 g[4];
#pragma unroll
    for (int j = 0; j < 4; ++j) g[j] = ((const f32x4*)gain)[lane + 64 * j];
    for (int r = gw; r < NSEQ * SEQ; r += ngw) {
        f32x4* hp = (f32x4*)(OUT + (size_t)r * DM) + lane;
        f32x4 v[4]; float s = 0.f;
#pragma unroll
        for (int j = 0; j < 4; ++j) { v[j] = hp[64 * j]; s += (v[j].x * v[j].x + v[j].y * v[j].y) + (v[j].z * v[j].z + v[j].w * v[j].w); }
        const float rstd = 1.0f / sqrtf(wave_sum(s, lane) * (1.0f / DM) + EPSN);
#pragma unroll
        for (int j = 0; j < 4; ++j) hp[64 * j] = v[j] * rstd * g[j];
    }
}
__device__ __forceinline__ void init_rows(const float* xp, const float* xs, const float* meta, float* LEAD, float* OUT, const float* gain, bf16_t* XN, float* SS, int gw, int ngw) {
    int lane = threadIdx.x; asm volatile("" : "+v"(lane)); lane &= 63; asm volatile("" : "+s"(ngw), "+s"(gw));
    f32x4 g[4];
#pragma unroll
    for (int j = 0; j < 4; ++j) g[j] = ((const f32x4*)gain)[lane + 64 * j];
    for (int r = gw; r < MROWS; r += ngw) {
        const int b = r / LP, s = r - b * LP;
        f32x4 v[4];
        if (s < 112) {
#pragma unroll
            for (int j = 0; j < 4; ++j) v[j] = (f32x4){0.f, 0.f, 0.f, 0.f};
        } else {
            const float* src = s < 128 ? meta + (size_t)(s - 112) * DM : (b < 2 ? xp + ((size_t)b * SEQ + (s - 128)) * DM : xs + ((size_t)(b - 2) * SEQ + (s - 128)) * DM);
#pragma unroll
            for (int j = 0; j < 4; ++j) v[j] = ((const f32x4*)src)[lane + 64 * j];
        }
        float sq = 0.f;
#pragma unroll
        for (int j = 0; j < 4; ++j) sq += (v[j].x * v[j].x + v[j].y * v[j].y) + (v[j].z * v[j].z + v[j].w * v[j].w);
        sq = wave_sum(sq, lane);
        if (lane == 0) SS[r] = sq;
        f32x4* hp = (f32x4*)hrow(LEAD, OUT, r) + lane;
        u32x2* o8 = (u32x2*)(XN + (size_t)r * DM) + lane;
#pragma unroll
        for (int j = 0; j < 4; ++j) { if (s < 128) hp[64 * j] = v[j]; const f32x4 y = v[j] * g[j]; u32x2 w; w.x = pk2(y.x, y.y); w.y = pk2(y.z, y.w); o8[64 * j] = w; }
    }
}
__device__ __forceinline__ void mla_rows(const bf16_t* U, const float* gcq, const float* gckv, const float* rope, bf16_t* XQ, bf16_t* XKV, bf16_t* KC, int gw, int ngw) {
    int lane = threadIdx.x; asm volatile("" : "+v"(lane)); lane &= 63; asm volatile("" : "+s"(ngw), "+s"(gw));
    const f32x4 gq = ((const f32x4*)gcq)[lane];
    const float gk0 = gckv[2 * lane], gk1 = gckv[2 * lane + 1];
    for (int r0 = gw; r0 < MROWS; r0 += 2 * ngw) {
        u32x2 cq[2]; unsigned ckv[2]; float krv[2], cs[2], sn[2]; int rr[2];
#pragma unroll
        for (int k = 0; k < 2; ++k) { int r = r0 + k * ngw; r = r < MROWS ? r : r0; rr[k] = r;
            const bf16_t* up = U + (size_t)r * DIN + 2048;
            cq[k] = *(const u32x2*)(up + 4 * lane); ckv[k] = *(const unsigned*)(up + 256 + 2 * lane); krv[k] = bf2f(up[384 + (lane & 31)]);
            const int s = r % LP, j = lane & 15; cs[k] = rope[(size_t)s * 32 + j]; sn[k] = rope[(size_t)s * 32 + 16 + j]; }
#pragma unroll
        for (int k = 0; k < 2; ++k) {
            if (k == 1 && r0 + ngw >= MROWS) break;
            const int r = rr[k];
            const float q0 = __builtin_bit_cast(float, cq[k].x << 16), q1 = __builtin_bit_cast(float, cq[k].x & 0xffff0000u), q2 = __builtin_bit_cast(float, cq[k].y << 16), q3 = __builtin_bit_cast(float, cq[k].y & 0xffff0000u);
            const float k0 = __builtin_bit_cast(float, ckv[k] << 16), k1 = __builtin_bit_cast(float, ckv[k] & 0xffff0000u);
            const float sq = wave_sum((q0 * q0 + q1 * q1) + (q2 * q2 + q3 * q3), lane), sk = wave_sum(k0 * k0 + k1 * k1, lane);
            const float rq = 1.0f / sqrtf(sq * (1.0f / 256.0f) + EPSN), rk = 1.0f / sqrtf(sk * (1.0f / 128.0f) + EPSN);
            u32x2 wq; wq.x = pk2(q0 * rq * gq.x, q1 * rq * gq.y); wq.y = pk2(q2 * rq * gq.z, q3 * rq * gq.w);
            *(u32x2*)(XQ + (size_t)r * 256 + 4 * lane) = wq;
            *(unsigned*)(XKV + (size_t)r * 128 + 2 * lane) = pk2(k0 * rk * gk0, k1 * rk * gk1);
            const float other = lane_xor(krv[k], lane, 16);
            const float ro = (lane & 16) ? (krv[k] * cs[k] + other * sn[k]) : (krv[k] * cs[k] - other * sn[k]);
            if (lane < 32) { const unsigned short ob = (unsigned short)f2bf(ro); bf16_t* kc = KC + (size_t)r * 384 + 64 + lane;
                kc[0] = ob; kc[96] = ob; kc[192] = ob; kc[288] = ob; }
        }
    }
}
#ifndef ATTN_FN
#define ATTN_FN attn_unit4
#endif
#ifndef REP_ATTN
#define REP_ATTN 1
#endif
#ifndef REP_GU
#define REP_GU 1
#endif
#define XB_TMO      128
#define XB_XCNT(j)  (256  + 64 * (j))
#define XB_XSUB(j)  (1280 + 64 * (j))
#define XB_XGEN(j)  (2304 + 64 * (j))
#define XB_TOP      3328
#define XB_TOPGEN   3392
#define XCD_BAR_WORDS 3456
#define XB_SPIN_CAP (1u << 18)

__device__ __forceinline__ unsigned xb_ld(unsigned* p)              { return __hip_atomic_load(p, __ATOMIC_RELAXED, __HIP_MEMORY_SCOPE_AGENT); }
__device__ __forceinline__ unsigned xb_add(unsigned* p, unsigned v) { return __hip_atomic_fetch_add(p, v, __ATOMIC_RELAXED, __HIP_MEMORY_SCOPE_AGENT); }
__device__ __forceinline__ unsigned xb_xcc_id() { return (unsigned)__builtin_amdgcn_s_getreg((3 << 11) | 20) & 0xFu; }
#define XB_SPIN(cond, bar) do { unsigned _sp = 0; while (cond) { __builtin_amdgcn_s_sleep(1); \
    if ((++_sp & 255u) == 0u) { if (xb_ld(&(bar)[XB_TMO])) break; if (_sp > XB_SPIN_CAP) { atomicAdd(&(bar)[XB_TMO], 1u); break; } } } } while (0)

struct XcdBarrier {
    unsigned* bar; unsigned x;
    volatile LAS unsigned* st;
};

__device__ __forceinline__ XcdBarrier xcd_barrier_post(unsigned* bar, volatile LAS unsigned* st) {
    XcdBarrier b; b.bar = bar; b.x = xb_xcc_id(); b.st = st;
    if (threadIdx.x == 0) (void)xb_add(&bar[XB_XCNT(b.x)], 1u);
    return b;
}
__device__ __forceinline__ void xcd_barrier_complete(unsigned* bar, unsigned x, unsigned& nloc, unsigned& nx) {
    const unsigned G = gridDim.x * gridDim.y * gridDim.z;
    unsigned sum, cnt, mine, sp = 0u;
    for (;;) {
        sum = 0u; cnt = 0u; mine = 0u;
#pragma unroll
        for (unsigned j = 0; j < 16; ++j) { const unsigned c = xb_ld(&bar[XB_XCNT(j)]); sum += c; cnt += (c > 0u) ? 1u : 0u; mine = (j == x) ? c : mine; }
        if (sum == G) break;
        __builtin_amdgcn_s_sleep(1);
        if ((++sp & 255u) == 0u) { if (xb_ld(&bar[XB_TMO])) break; if (sp > XB_SPIN_CAP) { atomicAdd(&bar[XB_TMO], 1u); break; } }
    }
    nloc = mine > 0u ? mine : 1u; nx = cnt > 0u ? cnt : 1u;
}

__device__ __forceinline__ void xcd_barrier(const XcdBarrier& b) {
    asm volatile("s_waitcnt vmcnt(0)" ::: "memory");
    __syncthreads();
    if (threadIdx.x == 0) {
        unsigned* bar = b.bar;
        __builtin_amdgcn_s_waitcnt(0);
        unsigned nloc = b.st[0], nx = b.st[1];
        if (nloc == 0u) { xcd_barrier_complete(bar, b.x, nloc, nx); b.st[0] = nloc; b.st[1] = nx; }
        const unsigned old = xb_add(&bar[XB_XSUB(b.x)], 1u);
        const unsigned gen = old / nloc;
        if (old + 1u == (gen + 1u) * nloc) {
            __builtin_amdgcn_fence(__ATOMIC_RELEASE, "agent");
            asm volatile("s_waitcnt vmcnt(0)" ::: "memory");
            const unsigned og = xb_add(&bar[XB_TOP], 1u);
            const unsigned tg = og / nx;
            if (og + 1u == (tg + 1u) * nx) xb_add(&bar[XB_TOPGEN], 1u);
            else XB_SPIN(xb_ld(&bar[XB_TOPGEN]) == tg, bar);
            __builtin_amdgcn_fence(__ATOMIC_ACQUIRE, "agent");
            xb_add(&bar[XB_XGEN(b.x)], 1u);
            asm volatile("s_waitcnt vmcnt(0)" ::: "memory");
        } else {
            XB_SPIN(xb_ld(&bar[XB_XGEN(b.x)]) == gen, bar);
            __builtin_amdgcn_fence(__ATOMIC_ACQUIRE, "agent");
            asm volatile("s_waitcnt vmcnt(0)" ::: "memory");
        }
    }
    __syncthreads();
}


constexpr int CW_BAR = 4096, CW_QUEUE = 64;
constexpr size_t CTL_ZERO_BYTES = 65536;
constexpr int MISC_OFF = 131072 + 320;
constexpr int I_GU = 16 * 176, I_D = 44 * 32, I_IN = 16 * 77, I_UQ = 4 * 12, I_UKV = 2 * 16, I_OUT = 16 * 32;
constexpr int I_LAYER = 2 * I_GU + 2 * I_D + I_IN + I_UQ + I_UKV + I_OUT;

struct KArgs { const float* in[21]; float* out; unsigned char* ws; float inv[16]; };

__global__ void __launch_bounds__(NTHR, 2) mega_fwd(KArgs a) {
    extern __shared__ __attribute__((aligned(16))) unsigned char lds_raw[];
    LAS unsigned char* lds = (LAS unsigned char*)lds_raw;
    cg::grid_group grid = cg::this_grid();
    const int wave = __builtin_amdgcn_readfirstlane(threadIdx.x >> 6);
    const int G = gridDim.x, bx = blockIdx.x;
    const int vcu = (G % 8 == 0) ? (bx % 8) * (G / 8) + bx / 8 : bx;
    const int gw = vcu * NWAVES + wave, ngw = G * NWAVES;
    unsigned char* const ws0 = a.ws;
    volatile LAS unsigned* MISC = (volatile LAS unsigned*)(lds + MISC_OFF);
    if (threadIdx.x < 32) MISC[threadIdx.x] = 0u;
    __syncthreads();
    (void)xcd_barrier_post((unsigned*)ws0 + CW_BAR, MISC + 8);
#define GRID_BAR() do { XcdBarrier xb_; xb_.bar = (unsigned*)ws0 + CW_BAR; xb_.x = xb_xcc_id(); xb_.st = (volatile LAS unsigned*)(lds + MISC_OFF) + 8; xcd_barrier(xb_); } while (0)

    {
        unsigned char* ws = ws0; float* LEAD = (float*)(ws + WS_LEAD); float* ROPE = (float*)(ws + WS_ROPE); float* OUT = a.out; bf16_t* XN = (bf16_t*)(ws + WS_XN);
        int tid = threadIdx.x; asm volatile("" : "+v"(tid)); const int lane = tid & 63;
        LAS float* scr = (LAS float*)(lds + wave * 16384);
#define CONVERT_ITEM(it_) do { const int it = (it_); \
            const int l = it / I_LAYER; int r = it - l * I_LAYER; \
            unsigned char* wl = ws + WS_W + (size_t)l * W_LAYER; \
            if (r < I_GU) { transpose_matrix_item<true>(a.in[5] + (size_t)l * 1024 * 5632, 1024, 5632, (bf16_t*)(wl + W_GU1), r, scr, lane); break; } r -= I_GU; \
            if (r < I_D) { transpose_matrix_item<false>(a.in[6] + (size_t)l * 2816 * 1024, 2816, 1024, (bf16_t*)(wl + W_D1), r, scr, lane); break; } r -= I_D; \
            if (r < I_IN) { transpose_matrix_item<false>(a.in[8] + (size_t)l * 1024 * DIN, 1024, DIN, (bf16_t*)(wl + W_IN), r, scr, lane); break; } r -= I_IN; \
            if (r < I_UQ) { transpose_matrix_item<false>(a.in[14] + (size_t)l * 256 * 384, 256, 384, (bf16_t*)(wl + W_UQ), r, scr, lane); break; } r -= I_UQ; \
            if (r < I_UKV) { transpose_matrix_item<false>(a.in[15] + (size_t)l * 128 * 512, 128, 512, (bf16_t*)(wl + W_UKV), r, scr, lane); break; } r -= I_UKV; \
            if (r < I_OUT) { transpose_matrix_item<false>(a.in[16] + (size_t)l * 1024 * 1024, 1024, 1024, (bf16_t*)(wl + W_OUT), r, scr, lane); break; } r -= I_OUT; \
            if (r < I_GU) { transpose_matrix_item<true>(a.in[18] + (size_t)l * 1024 * 5632, 1024, 5632, (bf16_t*)(wl + W_GU2), r, scr, lane); break; } r -= I_GU; \
            transpose_matrix_item<false>(a.in[19] + (size_t)l * 2816 * 1024, 2816, 1024, (bf16_t*)(wl + W_D2), r, scr, lane); \
         \
    } while (0)
        for (int it_ = gw; it_ < I_LAYER; it_ += ngw) CONVERT_ITEM(it_);
        const int gt = vcu * NTHR + tid, ngt = G * NTHR;
        for (int l = 0; l < 2; ++l) {
            u32x4* pin = (u32x4*)(ws + WS_W + (size_t)l * W_LAYER + W_IN + (size_t)DIN * 1024 * 2);
            for (int i = gt; i < 96 * 1024 * 2 / 16; i += ngt) pin[i] = (u32x4){0u, 0u, 0u, 0u};
            u32x4* puq = (u32x4*)(ws + WS_W + (size_t)l * W_LAYER + W_UQ + (size_t)384 * 256 * 2);
            for (int i = gt; i < 128 * 256 * 2 / 16; i += ngt) puq[i] = (u32x4){0u, 0u, 0u, 0u};
        }
        for (int i = gt; i < LP * 16; i += ngt) {
            const int s = i >> 4, j = i & 15;
            const float ang = (float)(s - 112) * a.inv[j];
            const double ad = (double)ang, kk = rint(ad * 0.15915494309189535);
            const float red = (float)(ad - kk * 6.283185307179586);
            ROPE[(size_t)s * 32 + j] = __cosf(red); ROPE[(size_t)s * 32 + 16 + j] = __sinf(red);
        }
        init_rows(a.in[0], a.in[1], a.in[2], LEAD, OUT, a.in[4], XN, (float*)(ws + WS_SS), gw, ngw);
    }
    if (a.ws == nullptr) grid.sync();
    GRID_BAR();

    int cons = 0;
#pragma unroll 1
    for (int i = 0; i < 4; ++i) {
        const int l = i >> 1;
        unsigned char* ws = ws0; asm volatile("" : "+s"(ws));
        float* LEAD = (float*)(ws + WS_LEAD); float* ROPE = (float*)(ws + WS_ROPE); float* OUT = a.out;
        bf16_t* XN = (bf16_t*)(ws + WS_XN); bf16_t* XQ = (bf16_t*)(ws + WS_XN + XQ_OFF); bf16_t* XKV = (bf16_t*)(ws + WS_XN + XKV_OFF);
        bf16_t* ACT = (bf16_t*)(ws + WS_BIG); bf16_t* U = (bf16_t*)(ws + WS_BIG + U_OFF); bf16_t* KC = (bf16_t*)(ws + WS_BIG + KC_OFF); bf16_t* VC = (bf16_t*)(ws + WS_BIG + VC_OFF);
        float* SSb = (float*)(ws + WS_SS);
        unsigned char* wl = ws + WS_W + (size_t)l * W_LAYER;
        {
            float* ssz = SSb + (size_t)((cons + 1) & 1) * MROWS; int t_ = threadIdx.x; asm volatile("" : "+v"(t_));
            { int st_ = G * NTHR; asm volatile("" : "+s"(st_)); float z_ = 0.f; asm volatile("" : "+v"(z_));
_Pragma("clang loop vectorize(disable) interleave(disable)")
              for (int r = vcu * NTHR + t_; r < MROWS; r += st_) ssz[r] = z_; }
            pg8::Gemm g{XN, (const bf16_t*)(wl + ((i & 1) ? W_GU2 : W_GU1)), MROWS, 5632, 1024}; pg8::StaticOrder S; S.init(MROWS, 5632, G, bx);
            pg8::EpiSwiGLU E{ACT, DFF, SSb + (size_t)(cons & 1) * MROWS};
            for (int rep_ = 0; rep_ < REP_GU; ++rep_) pg8::gemm_phase<pg8::EpiSwiGLU, pg8::StaticOrder, true, true>(lds, g, S, E);
        }
        GRID_BAR();
        {
            const float* gnext = (i & 1) ? ((i == 3) ? a.in[20] : a.in[4] + (size_t)(l + 1) * DM) : a.in[7] + (size_t)l * DM;
            pg8::Gemm g{ACT, (const bf16_t*)(wl + ((i & 1) ? W_D2 : W_D1)), MROWS, 1024, DFF}; pg8::StaticOrder S; S.init(MROWS, 1024, G, bx);
            if (i == 3) {
                pg8::EpiResidLast E{LEAD, OUT, 0.5f, XN, gnext, SSb + (size_t)((cons + 1) & 1) * MROWS, nullptr, nullptr};
                pg8::gemm_phase<pg8::EpiResidLast, pg8::StaticOrder, true, true>(lds, g, S, E);
            } else {
            pg8::EpiResid E{LEAD, OUT, 0.5f, XN, gnext, SSb + (size_t)((cons + 1) & 1) * MROWS, i == 0 ? a.in[0] : (const float*)nullptr, i == 0 ? a.in[1] : (const float*)nullptr};
            pg8::gemm_phase<pg8::EpiResid, pg8::StaticOrder, true, true>(lds, g, S, E);
            }
        }
        if (i == 0 && bx >= 20) {
            int tid = threadIdx.x; asm volatile("" : "+v"(tid)); const int lane = tid & 63;
            LAS float* scr = (LAS float*)(lds + wave * 16384);
            for (int it_ = I_LAYER + (bx - 20) * NWAVES + wave; it_ < 2 * I_LAYER; it_ += (G - 20) * NWAVES) CONVERT_ITEM(it_);
        }
        ++cons;
        GRID_BAR();
        if (i == 3) { final_rows(OUT, a.in[20], gw, ngw); break; }
        if (i & 1) continue;
        {
            float* ssz = SSb + (size_t)((cons + 1) & 1) * MROWS; int t_ = threadIdx.x; asm volatile("" : "+v"(t_));
            { int st_ = G * NTHR; asm volatile("" : "+s"(st_)); float z_ = 0.f; asm volatile("" : "+v"(z_));
_Pragma("clang loop vectorize(disable) interleave(disable)")
              for (int r = vcu * NTHR + t_; r < MROWS; r += st_) ssz[r] = z_; }
            pg8::Gemm g{XN, (const bf16_t*)(wl + W_IN), MROWS, DINP, 1024}; pg8::StaticOrder S; S.init(MROWS, DINP, G, bx);
            pg8::EpiU E{U, 0.125f * LOG2E, SSb + (size_t)(cons & 1) * MROWS};
            pg8::gemm_phase<pg8::EpiU, pg8::StaticOrder, true, true>(lds, g, S, E);
        }
        GRID_BAR();
        mla_rows(U, a.in[12] + (size_t)l * 256, a.in[13] + (size_t)l * 128, ROPE, XQ, XKV, KC, gw, ngw);
        GRID_BAR();
        {
            int kq = 256; asm volatile("" : "+s"(kq));
            pg8::Gemm g{XQ, (const bf16_t*)(wl + W_UQ), MROWS, 512, kq}; pg8::StaticOrder S; S.init(MROWS, 512, G, bx);
            pg8::EpiQC E{U, ROPE, 0.10206207261596575f * LOG2E};
            pg8::gemm_phase<pg8::EpiQC, pg8::StaticOrder, true, true>(lds, g, S, E);
        }
        {
            int kkv = 128; asm volatile("" : "+s"(kkv));
            pg8::Gemm g{XKV, (const bf16_t*)(wl + W_UKV), MROWS, 512, kkv}; pg8::StaticOrder S; S.init(MROWS, 512, G, bx);
            pg8::EpiKV E{KC, VC};
            pg8::gemm_phase<pg8::EpiKV, pg8::StaticOrder, true, true>(lds, g, S, E);
        }
        GRID_BAR();
        {
            AttnArgs A{U, KC, VC, (bf16_t*)(ws + WS_O), a.in[3], a.in[9] + (size_t)l * 256, a.in[10] + (size_t)l * 128, a.in[11] + (size_t)l * 4, 0.8f - 0.6f * __expf(-0.3f * (float)l)};
            constexpr int NA = NSEQ * 4 * 65, NC = NSEQ * 2 * 65, NB = NSEQ * 2 * 65;
            unsigned* qhead = (unsigned*)ws + CW_QUEUE + 64 * l;
            for (;;) {
                if (threadIdx.x == 0) MISC[16] = atomicAdd(qhead, 1u);
                __syncthreads();
                const int u = (int)MISC[16];
                __syncthreads();
                if (u >= NA + NC + NB) break;
                if (l == 1 && (u % 65) == 0) continue;
                if (u < NA) ATTN_FN<0>(lds, u, A);
                else if (u < NA + NC) ATTN_FN<1>(lds, u - NA, A);
                else ATTN_FN<2>(lds, u - NA - NC, A);
            }
        }
        GRID_BAR();
        {
            pg8::Gemm g{(const bf16_t*)(ws + WS_O), (const bf16_t*)(wl + W_OUT), MROWS, 1024, 1024}; pg8::StaticOrder S; S.init(MROWS, 1024, G, bx);
            pg8::EpiResid E{LEAD, OUT, 1.0f, XN, a.in[17] + (size_t)l * DM, SSb + (size_t)((cons + 1) & 1) * MROWS, nullptr, nullptr};
            pg8::gemm_phase<pg8::EpiResid, pg8::StaticOrder, true, true>(lds, g, S, E);
        }
        ++cons;
        GRID_BAR();
    }
}

extern "C" void kernel_launch(void* const* d_in, const int* in_sizes, int n_in, void* d_out, int out_size, void* d_ws, size_t ws_size, hipStream_t stream) {
    static int grid = 0;
    if (grid == 0) {
        if (n_in != 21 || ws_size < WS_END) { fprintf(stderr, "kernel_launch: unexpected inputs (n_in %d, ws %zu, need %zu)\n", n_in, ws_size, (size_t)WS_END); grid = -1; return; }
        int dev = 0, cus = 0, per_cu = 0;
        hipGetDevice(&dev); hipDeviceGetAttribute(&cus, hipDeviceAttributeMultiprocessorCount, dev);
        if (hipFuncSetAttribute((const void*)mega_fwd, hipFuncAttributeMaxDynamicSharedMemorySize, LDS_BYTES) != hipSuccess) { fprintf(stderr, "kernel_launch: hipFuncSetAttribute failed\n"); grid = -1; return; }
        hipOccupancyMaxActiveBlocksPerMultiprocessor(&per_cu, (const void*)mega_fwd, NTHR, LDS_BYTES);
        (void)hipGetLastError();
        if (per_cu < 1) { fprintf(stderr, "kernel_launch: occupancy query says %d blocks per CU\n", per_cu); per_cu = 1; }
        grid = cus;
    }
    if (grid < 0) return;
    if (hipMemsetAsync(d_ws, 0, CTL_ZERO_BYTES, stream) != hipSuccess) { fprintf(stderr, "kernel_launch: memset failed\n"); return; }
    KArgs a{};
    for (int i = 0; i < 21; ++i) a.in[i] = (const float*)d_in[i];
    a.out = (float*)d_out; a.ws = (unsigned char*)d_ws;
    for (int j = 0; j < 16; ++j) a.inv[j] = (float)pow(10000.0, -(double)(2 * j) / 32.0);
    void* args[] = {&a};
    hipError_t e = hipLaunchCooperativeKernel((const void*)mega_fwd, dim3(grid), dim3(NTHR), args, LDS_BYTES, stream);
    if (e != hipSuccess) fprintf(stderr, "kernel_launch: cooperative launch failed: %s (grid %d)\n", hipGetErrorString(e), grid);
}
```

```cpp
#include <hip/hip_runtime.h>
#include <hip/hip_cooperative_groups.h>
#include <cstdio>
#include <cstdint>
namespace cg = cooperative_groups;
#define LAS __attribute__((address_space(3)))
#define GAS __attribute__((address_space(1)))
typedef unsigned short bf16_t;
typedef short bf16x8 __attribute__((ext_vector_type(8)));
typedef float f32x4 __attribute__((ext_vector_type(4)));
typedef float f32x16 __attribute__((ext_vector_type(16)));
typedef unsigned u32x4 __attribute__((ext_vector_type(4)));
typedef unsigned u32x2 __attribute__((ext_vector_type(2)));
typedef short v4i16_t __attribute__((ext_vector_type(4)));

constexpr int NSEQ = 10, LP = 8320, SEQ = 8192, DM = 1024, DFF = 2816, DIN = 2464, DINP = 2560;
constexpr int MROWS = NSEQ * LP;
constexpr int NTHR = 512, NWAVES = 8;
constexpr float LOG2E = 1.4426950408889634f;
constexpr float NEGBIG = -1.0e30f;
constexpr float EPSN = 1e-6f;

constexpr size_t MiB = 1u << 20;
constexpr size_t W_GU1 = 0, W_D1 = W_GU1 + (size_t)5632 * 1024 * 2, W_IN = W_D1 + (size_t)1024 * 2816 * 2, W_UQ = W_IN + (size_t)DINP * 1024 * 2,
                 W_UKV = W_UQ + (size_t)512 * 256 * 2, W_OUT = W_UKV + (size_t)512 * 128 * 2, W_GU2 = W_OUT + (size_t)1024 * 1024 * 2,
                 W_D2 = W_GU2 + (size_t)5632 * 1024 * 2, W_LAYER = W_D2 + (size_t)1024 * 2816 * 2;
static_assert(W_LAYER == 42336256, "weights per layer");
constexpr size_t WS_W = 1 * MiB, WS_LEAD = 82 * MiB, WS_ROPE = 87 * MiB, WS_XN = 89 * MiB, WS_BIG = 252 * MiB;
static_assert(WS_W + 2 * W_LAYER <= WS_LEAD, "ws map");
constexpr size_t WS_SS = 88 * MiB + 256 * 1024;
static_assert(WS_ROPE + (size_t)LP * 32 * 4 <= WS_SS && WS_SS + 2 * (size_t)MROWS * 4 <= WS_XN, "ss map");
constexpr size_t XQ_OFF = 0, XKV_OFF = (size_t)MROWS * 256 * 2;
constexpr size_t U_OFF = 0, KC_OFF = 392 * MiB, VC_OFF = (392 + 61) * MiB, BIG_END = 494 * MiB;
static_assert((size_t)MROWS * DIN * 2 <= KC_OFF && KC_OFF + (size_t)MROWS * 384 * 2 <= VC_OFF && VC_OFF + (size_t)MROWS * 256 * 2 <= BIG_END, "big map");
static_assert((size_t)MROWS * DFF * 2 <= BIG_END && WS_XN + (size_t)MROWS * DM * 2 <= WS_BIG, "big map 2");
constexpr size_t WS_O = WS_BIG + BIG_END;
constexpr size_t WS_END = WS_O + (size_t)MROWS * DM * 2;
static_assert(WS_END <= (size_t)1024 * MiB, "ws budget");

constexpr int LDS_BYTES = 147456;

__device__ __forceinline__ float lane_xor(float v, int lane, int o) { return __builtin_bit_cast(float, __builtin_amdgcn_ds_bpermute((lane ^ o) << 2, __builtin_bit_cast(int, v))); }
__device__ __forceinline__ float wave_sum(float v, int lane) {
#pragma unroll
    for (int o = 1; o < 64; o <<= 1) v += lane_xor(v, lane, o);
    return v;
}
__device__ __forceinline__ unsigned f2bf(float f) { unsigned u = __builtin_bit_cast(unsigned, f); return (u + 0x7fffu + ((u >> 16) & 1u)) >> 16; }
__device__ __forceinline__ unsigned pk2(float lo, float hi) { return f2bf(lo) | (f2bf(hi) << 16); }
__device__ __forceinline__ float bf2f(unsigned short b) { return __builtin_bit_cast(float, (unsigned)b << 16); }

struct Args { const float* in[21]; float* out; unsigned char* ws; };

__device__ __forceinline__ float* hrow(float* LEAD, float* OUT, int r) {
    const int b = r / LP, s = r - b * LP;
    return s < 128 ? LEAD + ((size_t)(b * 128 + s)) * DM : OUT + ((size_t)b * SEQ + (s - 128)) * DM;
}
namespace pg8 {
#define PG8_LAS __attribute__((address_space(3)))
typedef unsigned short bf16_t;
typedef short bf16x8 __attribute__((ext_vector_type(8)));
typedef float f32x4 __attribute__((ext_vector_type(4)));
typedef unsigned u32x4 __attribute__((ext_vector_type(4)));
constexpr int BM = 256, BK = 64, HALF = 128, HTB = HALF * BK * 2  , STAGE_BYTES = 8 * HTB, NXCD = 8, WGM = 8;

__host__ __device__ __forceinline__ int lds_byte(int r, int c) { const int st = (r >> 4) * 2 + (c >> 5), rr = r & 15, cc = c & 31, ob = rr * 64 + cc * 2; return st * 1024 + (ob ^ (((ob >> 9) & 1) << 5)); }
__host__ __device__ __forceinline__ void stage_rc(int b, int& R, int& C) { const int st = b / 1024, sb = b % 1024, swz = sb ^ (((sb >> 9) & 1) << 5); R = (st >> 1) * 16 + swz / 64; C = (st & 1) * 32 + (swz % 64) / 2; }
__host__ __device__ __forceinline__ int perm32(int rho) { const int n = rho >> 4, i = rho & 15; return 8 * (i >> 2) + 4 * n + (i & 3); }

struct Unit { int pm, pn; };
struct Gemm { const bf16_t* A; const bf16_t* Bt; int M, N, K; };

struct StaticOrder {
    int nM, nN, nwg, G, c;
    __host__ __device__ void init(int M, int N, int G_, int c_) { nM = M / BM; nN = N / BM; nwg = nM * nN; G = G_; c = c_; }
    __host__ __device__ bool next(int i, Unit& u) const {
        const long L = (long)i * G + c; if (L >= nwg) return false;
        int wgid = (int)L; { const int q = nwg / NXCD, r = nwg % NXCD, xcd = wgid % NXCD, off = wgid / NXCD; wgid = (xcd < r ? xcd * (q + 1) : r * (q + 1) + (xcd - r) * q) + off; }
        const int nig = WGM * nN, gid = wgid / nig, fm = gid * WGM, gsz = (nM - fm) < WGM ? (nM - fm) : WGM;
        u.pm = fm + ((wgid % nig) % gsz); u.pn = (wgid % nig) / gsz; return true;
    }
    __device__ __forceinline__ void a_ready(const Unit&) const {}
    __device__ __forceinline__ void done(const Unit&) const {}
};

__device__ __forceinline__ unsigned cvt_pk_bf16(float lo, float hi) { unsigned r; asm volatile("v_cvt_pk_bf16_f32 %0, %1, %2" : "=v"(r) : "v"(lo), "v"(hi)); return r; }
typedef float f32x2 __attribute__((ext_vector_type(2)));
__device__ __forceinline__ float silu_mul(float g, float u) { return g * __builtin_amdgcn_rcpf(1.0f + __builtin_amdgcn_exp2f(-g * 1.4426950408889634f)) * u; }
__device__ __forceinline__ f32x2 silu_mul2(f32x2 g, f32x2 u, float kneg, float rs2) {
    const f32x2 t = g * kneg;
    f32x2 e; e.x = __builtin_amdgcn_exp2f(t.x); e.y = __builtin_amdgcn_exp2f(t.y);
    const f32x2 d = e + 1.0f;
    f32x2 r; r.x = __builtin_amdgcn_rcpf(d.x); r.y = __builtin_amdgcn_rcpf(d.y);
    return (g * u) * (r * rs2);
}
struct EpiSwiGLU {
    static constexpr bool PERM = true, AFTER_DRAIN = false;
    bf16_t* O; int ldo; const float* SS;
    __device__ __forceinline__ void operator()(const f32x4 (&acc)[2][2][4][2], const Unit& u, int wr, int wc, int fr_in, int fq_in) const {
        int t_ = threadIdx.x; asm volatile("" : "+v"(t_)); const int fr = t_ & 15, fq = (t_ >> 4) & 3;
        const int row0 = u.pm * BM + wr * 64 + fr, col0 = u.pn * 128 + wc * 32 + 8 * fq;
        float ssv[2][4];
#pragma unroll
        for (int ai = 0; ai < 2; ++ai)
#pragma unroll
            for (int m = 0; m < 4; ++m) ssv[ai][m] = SS[row0 + ai * HALF + m * 16];
#pragma unroll
        for (int ai = 0; ai < 2; ++ai)
#pragma unroll
            for (int m = 0; m < 4; ++m) {
                const int row = row0 + ai * HALF + m * 16;
                const float rs = __builtin_amdgcn_rsqf(ssv[ai][m] * (1.0f / 1024.0f) + 1e-6f);
                const float kneg = -1.4426950408889634f * rs, rs2 = rs * rs;
                bf16_t* rowp = O + (size_t)row * ldo + col0;
                const f32x4 g0 = acc[ai][0][m][0], g1 = acc[ai][0][m][1], u0 = acc[ai][1][m][0], u1 = acc[ai][1][m][1];
                const f32x2 a0 = silu_mul2((f32x2){g0[0], g0[1]}, (f32x2){u0[0], u0[1]}, kneg, rs2), a1 = silu_mul2((f32x2){g0[2], g0[3]}, (f32x2){u0[2], u0[3]}, kneg, rs2);
                const f32x2 a2 = silu_mul2((f32x2){g1[0], g1[1]}, (f32x2){u1[0], u1[1]}, kneg, rs2), a3 = silu_mul2((f32x2){g1[2], g1[3]}, (f32x2){u1[2], u1[3]}, kneg, rs2);
                u32x4 w; w.x = cvt_pk_bf16(a0.x, a0.y); w.y = cvt_pk_bf16(a1.x, a1.y); w.z = cvt_pk_bf16(a2.x, a2.y); w.w = cvt_pk_bf16(a3.x, a3.y);
                *(u32x4*)rowp = w;
            }
    }
};
struct EpiResid {
    static constexpr bool PERM = true, AFTER_DRAIN = false;
    float* LEAD; float* OUT; float alpha; bf16_t* XN; const float* gain; float* SSout;
    const float* XP; const float* XS;
    __device__ __forceinline__ void operator()(const f32x4 (&acc)[2][2][4][2], const Unit& u, int wr, int wc, int fr_in, int fq_in) const {
        int t_ = threadIdx.x; asm volatile("" : "+v"(t_)); const int fr = t_ & 15, fq = (t_ >> 4) & 3, lane = t_ & 63;
        const int row0 = u.pm * BM + wr * 64 + fr, col0 = u.pn * BM + wc * 32 + 8 * fq;
        f32x4 gv[2][2];
#pragma unroll
        for (int bj = 0; bj < 2; ++bj) { gv[bj][0] = *(const f32x4*)(gain + col0 + bj * HALF); gv[bj][1] = *(const f32x4*)(gain + col0 + bj * HALF + 4); }
#pragma unroll
        for (int ai = 0; ai < 2; ++ai) {
            float* hp[4]; f32x4 hv[4][2][2];
#pragma unroll
            for (int m = 0; m < 4; ++m) { const int rw = row0 + ai * HALF + m * 16; hp[m] = hrow(LEAD, OUT, rw) + col0;
                const float* sp = hp[m];
                if (XP) { const int b = rw / LP, sl = rw - b * LP; if (sl >= 128) sp = (b < 2 ? XP + ((size_t)b * SEQ + (sl - 128)) * DM : XS + ((size_t)(b - 2) * SEQ + (sl - 128)) * DM) + col0; }
#pragma unroll
                for (int bj = 0; bj < 2; ++bj) { hv[m][bj][0] = *(const f32x4*)(sp + bj * HALF); hv[m][bj][1] = *(const f32x4*)(sp + bj * HALF + 4); } }
#pragma unroll
            for (int m = 0; m < 4; ++m) {
                const int row = row0 + ai * HALF + m * 16;
                bf16_t* xp = XN + (size_t)row * DM + col0;
                float sq = 0.f;
#pragma unroll
                for (int bj = 0; bj < 2; ++bj) {
                    const f32x4 a = hv[m][bj][0] + acc[ai][bj][m][0] * alpha, b = hv[m][bj][1] + acc[ai][bj][m][1] * alpha;
                    *(f32x4*)(hp[m] + bj * HALF) = a; *(f32x4*)(hp[m] + bj * HALF + 4) = b;
                    sq += (a[0] * a[0] + a[1] * a[1]) + (a[2] * a[2] + a[3] * a[3]) + (b[0] * b[0] + b[1] * b[1]) + (b[2] * b[2] + b[3] * b[3]);
                    const f32x4 xa = a * gv[bj][0], xb = b * gv[bj][1];
                    u32x4 w; w.x = cvt_pk_bf16(xa[0], xa[1]); w.y = cvt_pk_bf16(xa[2], xa[3]); w.z = cvt_pk_bf16(xb[0], xb[1]); w.w = cvt_pk_bf16(xb[2], xb[3]);
                    *(u32x4*)(xp + bj * HALF) = w;
                }
                sq += lane_xor(sq, lane, 16); sq += lane_xor(sq, lane, 32);
                if (fq == 0) atomicAdd(SSout + row, sq);
            }
        }
    }
};
struct EpiResidLast {
    static constexpr bool PERM = true, AFTER_DRAIN = false;
    float* LEAD; float* OUT; float alpha; bf16_t* XN; const float* gain; float* SSout;
    const float* XP; const float* XS;
    __device__ __forceinline__ void operator()(const f32x4 (&acc)[2][2][4][2], const Unit& u, int wr, int wc, int fr_in, int fq_in) const {
        int t_ = threadIdx.x; asm volatile("" : "+v"(t_)); const int fr = t_ & 15, fq = (t_ >> 4) & 3, lane = t_ & 63;
        const int row0 = u.pm * BM + wr * 64 + fr, col0 = u.pn * BM + wc * 32 + 8 * fq;
        f32x4 gv[2][2];
#pragma unroll
        for (int bj = 0; bj < 2; ++bj) { gv[bj][0] = *(const f32x4*)(gain + col0 + bj * HALF); gv[bj][1] = *(const f32x4*)(gain + col0 + bj * HALF + 4); }
#pragma unroll
        for (int ai = 0; ai < 2; ++ai) {
            float* hp[4]; f32x4 hv[4][2][2];
#pragma unroll
            for (int m = 0; m < 4; ++m) { const int rw = row0 + ai * HALF + m * 16; hp[m] = hrow(LEAD, OUT, rw) + col0;
                const float* sp = hp[m];
                if (XP) { const int b = rw / LP, sl = rw - b * LP; if (sl >= 128) sp = (b < 2 ? XP + ((size_t)b * SEQ + (sl - 128)) * DM : XS + ((size_t)(b - 2) * SEQ + (sl - 128)) * DM) + col0; }
#pragma unroll
                for (int bj = 0; bj < 2; ++bj) { hv[m][bj][0] = *(const f32x4*)(sp + bj * HALF); hv[m][bj][1] = *(const f32x4*)(sp + bj * HALF + 4); } }
#pragma unroll
            for (int m = 0; m < 4; ++m) {
                const int row = row0 + ai * HALF + m * 16;
                bf16_t* xp = XN + (size_t)row * DM + col0;
                float sq = 0.f;
#pragma unroll
                for (int bj = 0; bj < 2; ++bj) {
                    const f32x4 a = hv[m][bj][0] + acc[ai][bj][m][0] * alpha, b = hv[m][bj][1] + acc[ai][bj][m][1] * alpha;
                    *(f32x4*)(hp[m] + bj * HALF) = a; *(f32x4*)(hp[m] + bj * HALF + 4) = b;
                    sq += (a[0] * a[0] + a[1] * a[1]) + (a[2] * a[2] + a[3] * a[3]) + (b[0] * b[0] + b[1] * b[1]) + (b[2] * b[2] + b[3] * b[3]);
                }
            }
        }
    }
};
struct EpiU {
    static constexpr bool PERM = true, AFTER_DRAIN = false;
    bf16_t* U; float qs; const float* SS;
    __device__ __forceinline__ void operator()(const f32x4 (&acc)[2][2][4][2], const Unit& u, int wr, int wc, int fr_in, int fq_in) const {
        int t_ = threadIdx.x; asm volatile("" : "+v"(t_)); const int fr = t_ & 15, fq = (t_ >> 4) & 3;
        const int row0 = u.pm * BM + wr * 64 + fr, col0 = u.pn * BM + wc * 32 + 8 * fq;
        const float sc = (u.pn < 2 || u.pn == 6) ? qs : 1.0f;
        float ssv[2][4];
#pragma unroll
        for (int ai = 0; ai < 2; ++ai)
#pragma unroll
            for (int m = 0; m < 4; ++m) ssv[ai][m] = SS[row0 + ai * HALF + m * 16];
#pragma unroll
        for (int ai = 0; ai < 2; ++ai)
#pragma unroll
            for (int m = 0; m < 4; ++m) {
                const int row = row0 + ai * HALF + m * 16;
                const float rs = __builtin_amdgcn_rsqf(ssv[ai][m] * (1.0f / 1024.0f) + 1e-6f) * sc;
                bf16_t* rowp = U + (size_t)row * DIN + col0;
#pragma unroll
                for (int bj = 0; bj < 2; ++bj) {
                    if (col0 + bj * HALF < DIN) {
                        const f32x4 v0 = acc[ai][bj][m][0] * rs, v1 = acc[ai][bj][m][1] * rs;
                        u32x4 w; w.x = cvt_pk_bf16(v0[0], v0[1]); w.y = cvt_pk_bf16(v0[2], v0[3]); w.z = cvt_pk_bf16(v1[0], v1[1]); w.w = cvt_pk_bf16(v1[2], v1[3]);
                        *(u32x4*)(rowp + bj * HALF) = w;
                    }
                }
            }
    }
};
struct EpiQC {
    static constexpr bool PERM = false, AFTER_DRAIN = false;
    bf16_t* U; const float* rope; float qs;
    __device__ __forceinline__ void operator()(const f32x4 (&acc)[2][2][4][2], const Unit& u, int wr, int wc, int fr_in, int fq_in) const {
        int t_ = threadIdx.x; asm volatile("" : "+v"(t_)); const int fr = t_ & 15, fq = (t_ >> 4) & 3;
        const int row0 = u.pm * BM + wr * 64 + fr;
#pragma unroll
        for (int bj = 0; bj < 2; ++bj) {
            const int cg0 = u.pn * BM + bj * HALF + wc * 32;
            if (cg0 >= 384) continue;
            const bool isrope = ((cg0 >> 5) % 3) == 2;
#pragma unroll
            for (int ai = 0; ai < 2; ++ai)
#pragma unroll
                for (int m = 0; m < 4; ++m) {
                    const int r = row0 + ai * HALF + m * 16;
                    f32x4 x1 = acc[ai][bj][m][0] * qs, x2 = acc[ai][bj][m][1] * qs;
                    if (isrope) {
                        const int s = r % LP;
                        const f32x4 cs = *(const f32x4*)(rope + (size_t)s * 32 + 4 * fq), sn = *(const f32x4*)(rope + (size_t)s * 32 + 16 + 4 * fq);
                        const f32x4 o1 = x1 * cs - x2 * sn, o2 = x2 * cs + x1 * sn; x1 = o1; x2 = o2;
                    }
                    bf16_t* p = U + (size_t)r * DIN + 2048 + cg0 + 4 * fq;
                    u32x2 w1, w2; w1.x = cvt_pk_bf16(x1[0], x1[1]); w1.y = cvt_pk_bf16(x1[2], x1[3]); w2.x = cvt_pk_bf16(x2[0], x2[1]); w2.y = cvt_pk_bf16(x2[2], x2[3]);
                    *(u32x2*)p = w1; *(u32x2*)(p + 16) = w2;
                }
        }
    }
};
struct EpiKV {
    static constexpr bool PERM = true, AFTER_DRAIN = false;
    bf16_t* KC; bf16_t* VC;
    __device__ __forceinline__ void operator()(const f32x4 (&acc)[2][2][4][2], const Unit& u, int wr, int wc, int fr_in, int fq_in) const {
        int t_ = threadIdx.x; asm volatile("" : "+v"(t_)); const int fr = t_ & 15, fq = (t_ >> 4) & 3;
        const int row0 = u.pm * BM + wr * 64 + fr;
#pragma unroll
        for (int ai = 0; ai < 2; ++ai)
#pragma unroll
            for (int m = 0; m < 4; ++m) {
                const size_t r = (size_t)(row0 + ai * HALF + m * 16);
#pragma unroll
                for (int bj = 0; bj < 2; ++bj) {
                    const int hh = u.pn * 2 + bj;
                    const f32x4 v0 = acc[ai][bj][m][0], v1 = acc[ai][bj][m][1];
                    u32x4 w; w.x = cvt_pk_bf16(v0[0], v0[1]); w.y = cvt_pk_bf16(v0[2], v0[3]); w.z = cvt_pk_bf16(v1[0], v1[1]); w.w = cvt_pk_bf16(v1[2], v1[3]);
                    bf16_t* p = (wc < 2) ? KC + r * 384 + hh * 96 + wc * 32 + 8 * fq : VC + r * 256 + hh * 64 + (wc - 2) * 32 + 8 * fq;
                    *(u32x4*)p = w;
                }
            }
    }
};
template <class Epi, class Sched, bool ALIGN_EPI = false, bool SP2 = false>
__device__ __forceinline__ void gemm_phase(PG8_LAS unsigned char* lds, const Gemm g, const Sched& S, const Epi& E) {
    int tid_ = threadIdx.x; asm volatile("" : "+v"(tid_));
    const int tid = tid_, wid = __builtin_amdgcn_readfirstlane(tid >> 6), lane = tid & 63, wr = wid >> 2, wc = wid & 3, fr = lane & 15, fq = lane >> 4;
    const int K = g.K, nt = K / BK;
    unsigned voffA[2], voffB[2];
#pragma unroll
    for (int i = 0; i < 2; ++i) { int R, C; stage_rc(tid * 16 + i * 8192, R, C); const int Rb = Epi::PERM ? ((R & ~31) + perm32(R & 31)) : R;
        voffA[i] = (unsigned)(R * K + C) * 2u; voffB[i] = (unsigned)(Rb * K + C) * 2u; }
    const size_t kstep = (size_t)(BK * 2);
    const size_t hstep = (size_t)HALF * K * 2;
    const size_t tstep = 2 * hstep;
    const unsigned ldsw = (unsigned)wid * 1024u;
    const int aoff = lds_byte(wr * 64 + fr, fq * 8), boff = lds_byte(wc * 32 + fr, fq * 8);
#define PG8_SA(b, h) (((b) * 2 + (h)) * HTB)
#define PG8_SB(b, h) ((4 + (b) * 2 + (h)) * HTB)
#define PG8_STAGE(bufoff, gbase, voff) do { _Pragma("unroll") for (int _i = 0; _i < 2; ++_i) \
        __builtin_amdgcn_global_load_lds((const unsigned*)((const char*)(gbase) + (voff)[_i]), (PG8_LAS unsigned*)(lds + (bufoff) + ldsw + _i * 8192), 16, 0, 0); } while (0)
#define PG8_LDA(dst, b, h) do { _Pragma("unroll") for (int m = 0; m < 4; ++m) _Pragma("unroll") for (int k = 0; k < 2; ++k) dst[m][k] = *(const PG8_LAS bf16x8*)(lds + PG8_SA(b, h) + aoff + m * 2048 + k * 1024); } while (0)
#define PG8_LDB(dst, b, h) do { _Pragma("unroll") for (int n = 0; n < 2; ++n) _Pragma("unroll") for (int k = 0; k < 2; ++k) dst[n][k] = *(const PG8_LAS bf16x8*)(lds + PG8_SB(b, h) + boff + n * 2048 + k * 1024); } while (0)
#define PG8_MMA(ai, bj, At, Bt) do { __builtin_amdgcn_s_setprio(1); _Pragma("unroll") for (int m = 0; m < 4; ++m) _Pragma("unroll") for (int n = 0; n < 2; ++n) _Pragma("unroll") for (int k = 0; k < 2; ++k) \
        acc[ai][bj][m][n] = __builtin_amdgcn_mfma_f32_16x16x32_bf16(Bt[n][k], At[m][k], acc[ai][bj][m][n], 0, 0, 0); __builtin_amdgcn_s_setprio(0); } while (0)
#define PG8_WAIT_V(n) asm volatile("s_waitcnt vmcnt(" #n ")" ::: "memory")
#define PG8_WAIT_L(n) asm volatile("s_waitcnt lgkmcnt(" #n ")" ::: "memory")
#define PG8_BAR __builtin_amdgcn_s_barrier()
#define PG8_SCHED __builtin_amdgcn_sched_barrier(0)
    Unit cur, nxt; int ui = 0;
    if (!S.next(0, cur)) return;
    f32x4 acc[2][2][4][2];
#pragma unroll
    for (int a = 0; a < 2; ++a)
#pragma unroll
        for (int b = 0; b < 2; ++b)
#pragma unroll
            for (int m = 0; m < 4; ++m)
#pragma unroll
                for (int n = 0; n < 2; ++n) acc[a][b][m][n] = (f32x4){0.f, 0.f, 0.f, 0.f};
    bf16x8 At[4][2], B0[2][2], B1[2][2];
    const char* cA = (const char*)g.A + (size_t)cur.pm * tstep; const char* cB = (const char*)g.Bt + (size_t)cur.pn * tstep;
    S.a_ready(cur);
    if constexpr (SP2) {
        PG8_STAGE(PG8_SB(0, 0), cB, voffB); PG8_STAGE(PG8_SB(0, 1), cB + hstep, voffB); PG8_STAGE(PG8_SA(0, 0), cA, voffA); PG8_STAGE(PG8_SA(0, 1), cA + hstep, voffA);
        if (wr == 1) PG8_BAR;
        PG8_WAIT_V(2); PG8_BAR;
        PG8_STAGE(PG8_SB(1, 0), cB + kstep, voffB); PG8_STAGE(PG8_SA(1, 0), cA + kstep, voffA); PG8_STAGE(PG8_SB(1, 1), cB + hstep + kstep, voffB);
        PG8_WAIT_V(6); PG8_BAR;
    } else {
        PG8_STAGE(PG8_SB(0, 0), cB, voffB); PG8_STAGE(PG8_SA(0, 0), cA, voffA); PG8_STAGE(PG8_SB(0, 1), cB + hstep, voffB); PG8_STAGE(PG8_SA(0, 1), cA + hstep, voffA);
        if (wr == 1) PG8_BAR;
        PG8_WAIT_V(4); PG8_BAR;
        PG8_STAGE(PG8_SB(1, 0), cB + kstep, voffB); PG8_STAGE(PG8_SA(1, 0), cA + kstep, voffA); PG8_STAGE(PG8_SB(1, 1), cB + hstep + kstep, voffB);
        PG8_WAIT_V(6); PG8_BAR;
    }
    for (;;) {
        const bool has_next = S.next(ui + 1, nxt);
        const char* nA = has_next ? (const char*)g.A + (size_t)nxt.pm * tstep : cA; const char* nB = has_next ? (const char*)g.Bt + (size_t)nxt.pn * tstep : cB;
        for (int t = 0; t < nt; t += 2) {
            const bool last = (t == nt - 2);
            const char* a1 = cA + (size_t)(t + 1) * kstep;
            const char* a2 = last ? nA : cA + (size_t)(t + 2) * kstep; const char* b2 = last ? nB : cB + (size_t)(t + 2) * kstep;
            const char* a3 = a2 + kstep; const char* b3 = b2 + kstep;
            if (last && has_next) S.a_ready(nxt);
            if constexpr (SP2) {
            PG8_LDB(B0, 0, 0); PG8_LDB(B1, 0, 1); PG8_SCHED; PG8_LDA(At, 0, 0); PG8_STAGE(PG8_SA(1, 1), a1 + hstep, voffA);
            PG8_WAIT_V(8); PG8_WAIT_L(0); PG8_BAR; PG8_MMA(0, 0, At, B0); PG8_MMA(0, 1, At, B1); PG8_BAR; PG8_SCHED;
            PG8_LDA(At, 0, 1); PG8_STAGE(PG8_SB(0, 0), b2, voffB); PG8_STAGE(PG8_SB(0, 1), b2 + hstep, voffB); PG8_STAGE(PG8_SA(0, 0), a2, voffA);
            PG8_WAIT_V(8); PG8_WAIT_L(0); PG8_BAR; PG8_MMA(1, 0, At, B0); PG8_MMA(1, 1, At, B1); PG8_BAR; PG8_SCHED;
            PG8_LDB(B0, 1, 0); PG8_LDB(B1, 1, 1); PG8_SCHED; PG8_LDA(At, 1, 0); PG8_STAGE(PG8_SA(0, 1), a2 + hstep, voffA);
            PG8_WAIT_V(8); PG8_WAIT_L(0); PG8_BAR; PG8_MMA(0, 0, At, B0); PG8_MMA(0, 1, At, B1); PG8_BAR; PG8_SCHED;
            PG8_LDA(At, 1, 1); PG8_STAGE(PG8_SB(1, 0), b3, voffB); PG8_STAGE(PG8_SB(1, 1), b3 + hstep, voffB); PG8_STAGE(PG8_SA(1, 0), a3, voffA);
            PG8_WAIT_V(8); PG8_WAIT_L(0); PG8_BAR; PG8_MMA(1, 0, At, B0); PG8_MMA(1, 1, At, B1); PG8_BAR; PG8_SCHED;
            } else {
            PG8_LDB(B0, 0, 0); PG8_SCHED; PG8_LDA(At, 0, 0); PG8_STAGE(PG8_SA(1, 1), a1 + hstep, voffA);
            PG8_WAIT_L(8); PG8_BAR; PG8_WAIT_L(0); PG8_MMA(0, 0, At, B0); PG8_BAR; PG8_SCHED;
            PG8_LDB(B1, 0, 1); PG8_STAGE(PG8_SB(0, 0), b2, voffB);
            PG8_BAR; PG8_WAIT_L(0); PG8_MMA(0, 1, At, B1); PG8_BAR;
            PG8_LDA(At, 0, 1); PG8_STAGE(PG8_SA(0, 0), a2, voffA);
            PG8_BAR; PG8_WAIT_L(0); PG8_MMA(1, 0, At, B0); PG8_BAR; PG8_SCHED;
            PG8_STAGE(PG8_SB(0, 1), b2 + hstep, voffB);
            PG8_WAIT_V(6); PG8_BAR; PG8_MMA(1, 1, At, B1); PG8_BAR;
            PG8_LDB(B0, 1, 0); PG8_SCHED; PG8_LDA(At, 1, 0); PG8_STAGE(PG8_SA(0, 1), a2 + hstep, voffA);
            PG8_WAIT_L(8); PG8_BAR; PG8_WAIT_L(0); PG8_MMA(0, 0, At, B0); PG8_BAR; PG8_SCHED;
            PG8_LDB(B1, 1, 1); PG8_STAGE(PG8_SB(1, 0), b3, voffB);
            PG8_BAR; PG8_WAIT_L(0); PG8_MMA(0, 1, At, B1); PG8_BAR;
            PG8_LDA(At, 1, 1); PG8_STAGE(PG8_SA(1, 0), a3, voffA);
            PG8_BAR; PG8_WAIT_L(0); PG8_MMA(1, 0, At, B0); PG8_BAR; PG8_SCHED;
            PG8_STAGE(PG8_SB(1, 1), b3 + hstep, voffB);
            PG8_WAIT_V(6); PG8_BAR; PG8_MMA(1, 1, At, B1); PG8_BAR;
            }
        }
        if constexpr (ALIGN_EPI) { if (wr == 0) PG8_BAR; }
        if constexpr (!Epi::AFTER_DRAIN) { E(acc, cur, wr, wc, fr, fq); S.done(cur); }
        if (!has_next) break;
#pragma unroll
        for (int a = 0; a < 2; ++a)
#pragma unroll
            for (int b = 0; b < 2; ++b)
#pragma unroll
                for (int m = 0; m < 4; ++m)
#pragma unroll
                    for (int n = 0; n < 2; ++n) acc[a][b][m][n] = (f32x4){0.f, 0.f, 0.f, 0.f};
        cur = nxt; cA = nA; cB = nB; ++ui;
        if constexpr (ALIGN_EPI) { if (wr == 1) PG8_BAR; }
    }
    PG8_WAIT_V(0);
    if constexpr (!ALIGN_EPI) { if (wr == 0) PG8_BAR; }
    PG8_BAR;
    if constexpr (Epi::AFTER_DRAIN) { E.fused(acc, cur, wr, wc, fr, fq, lds, wid, lane); S.done(cur); }
#undef PG8_SA
#undef PG8_SB
#undef PG8_STAGE
#undef PG8_LDA
#undef PG8_LDB
#undef PG8_MMA
#undef PG8_WAIT_V
#undef PG8_WAIT_L
#undef PG8_BAR
#undef PG8_SCHED
}
}
__device__ __forceinline__ void transpose_item(const float* W, int K, int N, bf16_t* WT, int k0, int n0, int drow0, LAS float* scr, int lane) {
#pragma unroll 8
    for (int i = 0; i < 32; ++i) { const int kk = 2 * i + (lane >> 5); scr[kk * 33 + (lane & 31)] = W[(size_t)(k0 + kk) * N + n0 + (lane & 31)]; }
    asm volatile("s_waitcnt lgkmcnt(0)" ::: "memory");
    const int c = lane & 7;
#pragma unroll
    for (int j = 0; j < 4; ++j) { const int n = (lane >> 3) + 8 * j; const LAS float* s = scr + (8 * c) * 33 + n;
        u32x4 o; o.x = pk2(s[0 * 33], s[1 * 33]); o.y = pk2(s[2 * 33], s[3 * 33]); o.z = pk2(s[4 * 33], s[5 * 33]); o.w = pk2(s[6 * 33], s[7 * 33]);
        *(u32x4*)(WT + (size_t)(drow0 + n) * K + k0 + 8 * c) = o; }
    asm volatile("s_waitcnt lgkmcnt(0)" ::: "memory");
}
template <bool GU> __device__ __forceinline__ void transpose_matrix_item(const float* W, int K, int N, bf16_t* WT, int item, LAS float* scr, int lane) {
    const int nblk = N / 32, kb = item / nblk, nb = item % nblk, n0 = 32 * nb;
    int drow0 = n0;
    if (GU) { const int isu = n0 >= DFF ? 1 : 0, ff0 = n0 - isu * DFF; drow0 = 256 * (ff0 >> 7) + 128 * isu + (ff0 & 127); }
    transpose_item(W, K, N, WT, 64 * kb, n0, drow0, scr, lane);
}

__device__ __forceinline__ int t5_bucket_dev(int rel) {
    const int n = rel < 0 ? -rel : rel;
    int b = n < 8 ? n : n < 12 ? 8 : n < 16 ? 9 : n < 23 ? 10 : n < 32 ? 11 : n < 46 ? 12 : n < 64 ? 13 : n < 91 ? 14 : 15;
    return b + (rel > 0 ? 16 : 0);
}
struct AttnArgs { const bf16_t* U; const bf16_t* KC; const bf16_t* VC; bf16_t* O; const float* rel_bias; const float* dl; const float* gsub; const float* sinks; float lam_init; };

__device__ __forceinline__ float max3f(float a, float b, float c) { float r; asm("v_max3_f32 %0, %1, %2, %3" : "=v"(r) : "v"(a), "v"(b), "v"(c)); return r; }
__device__ __forceinline__ float swapmax(float m) { auto rr = __builtin_amdgcn_permlane32_swap(__float_as_uint(m), __float_as_uint(m), false, false); return fmaxf(__uint_as_float(rr[0]), __uint_as_float(rr[1])); }
__device__ __forceinline__ float swapsum(float m) { auto rr = __builtin_amdgcn_permlane32_swap(__float_as_uint(m), __float_as_uint(m), false, false); return __uint_as_float(rr[0]) + __uint_as_float(rr[1]); }
typedef float f32x2_t __attribute__((ext_vector_type(2))); typedef __bf16 bf16x2_t __attribute__((ext_vector_type(2)));
__device__ __forceinline__ unsigned cvtpk(float lo, float hi) { f32x2_t v = {lo, hi}; bf16x2_t b = __builtin_convertvector(v, bf16x2_t); return __builtin_bit_cast(unsigned, b); }

template <int MODE> __device__ __forceinline__ void attn_unit(LAS unsigned char* lds, const int uidx, const AttnArgs& A) {
    constexpr int DQK = MODE == 1 ? 96 : 64, DV = MODE == 0 ? 128 : 64;
    constexpr int KCH = MODE == 0 ? 16 : (MODE == 1 ? 24 : 8), VCH = MODE == 2 ? 8 : 16;
    constexpr int KSTR = KCH * 16 + 16, VSTR = 320;
    constexpr int KSOFF = MODE == 0 ? 128 : (MODE == 1 ? 192 : 0), VSOFF = MODE == 1 ? 128 : 0;
    constexpr int NKL = KCH * 64 / NTHR, NVL = VCH * 64 / NTHR;
    constexpr int KOFF = 0, VOFF = 25600, BUFB = 46080, TABOFF = 92160;
    constexpr int NKC = DQK / 16, NDB = DV / 32;
    int tid = threadIdx.x; asm volatile("" : "+v"(tid));
    const int lane = tid & 63, wid = __builtin_amdgcn_readfirstlane(tid >> 6), r32 = lane & 31, hi = lane >> 5, qg = wid & 3, st = wid >> 2;
    const int qb = uidx % 65, bh = uidx / 65;
    const int NH = MODE == 0 ? 4 : 2;
    const int b = bh / NH, hx = bh % NH;
    const size_t row0 = (size_t)b * LP;
    const bf16_t *Kg, *Vg, *Qg; int kld, vld;
    if (MODE == 0) { Kg = A.U + 512 + hx * 128; kld = DIN; Vg = A.U + 1024 + hx * 128; vld = DIN; Qg = A.U + hx * 128 + st * 64; }
    else if (MODE == 1) { Kg = A.KC + hx * 192; kld = 384; Vg = A.VC + hx * 128; vld = 256; Qg = A.U + 2048 + (2 * hx + st) * 96; }
    else { Kg = A.U + 1792 + hx * 64; kld = DIN; Vg = A.U + 1920 + hx * 64; vld = DIN; Qg = A.U + 1536 + (2 * hx + st) * 64; }
    int t0 = 1, t1 = 130;
    if (MODE == 2) { t0 = 2 * (qb - 1); if (t0 < 1) t0 = 1; t1 = 2 * (qb + 2); if (t1 > 130) t1 = 130; }
    LAS float* tab = (LAS float*)(lds + TABOFF);
    if (MODE != 1) {
        const int rel = tid - 256; const int bk = t5_bucket_dev(rel);
        if (MODE == 0) { tab[tid] = A.rel_bias[bk * 8 + hx] * LOG2E; }
        else { const bool okw = (rel <= 128 && rel >= -128);
            tab[tid] = okw ? A.rel_bias[bk * 8 + 4 + 2 * hx] * LOG2E : NEGBIG; tab[512 + tid] = okw ? A.rel_bias[bk * 8 + 4 + 2 * hx + 1] * LOG2E : NEGBIG; }
    }
    const int qslot0 = qb * 128 + qg * 32;
    bf16x8 qf[NKC];
    { const bf16_t* qp = Qg + (row0 + qslot0 + r32) * DIN + hi * 8;
#pragma unroll
      for (int kc = 0; kc < NKC; ++kc) qf[kc] = *(const bf16x8*)(qp + kc * 16); }
    int ksrc[NKL], kdst[NKL], vsrc[NVL], vdst[NVL];
#pragma unroll
    for (int i = 0; i < NKL; ++i) { const int id = tid + NTHR * i, key = id / KCH, ch = id % KCH; ksrc[i] = key * kld + ch * 8; kdst[i] = KOFF + key * KSTR + ch * 16; }
#pragma unroll
    for (int i = 0; i < NVL; ++i) { const int id = tid + NTHR * i, key = id / VCH, ch = id % VCH; vsrc[i] = key * vld + ch * 8; vdst[i] = VOFF + key * VSTR + ch * 16; }
    u32x4 kst[NKL], vst[NVL];
#define ATT_ISSUE(t) do { const bf16_t* kp_ = Kg + (row0 + 64 * (size_t)(t)) * kld; const bf16_t* vp_ = Vg + (row0 + 64 * (size_t)(t)) * vld; \
        _Pragma("unroll") for (int i = 0; i < NKL; ++i) kst[i] = *(const u32x4*)(kp_ + ksrc[i]); \
        _Pragma("unroll") for (int i = 0; i < NVL; ++i) vst[i] = *(const u32x4*)(vp_ + vsrc[i]); } while (0)
#define ATT_COMMIT(buf) do { LAS unsigned char* bb_ = lds + (buf) * BUFB; \
        _Pragma("unroll") for (int i = 0; i < NKL; ++i) *(LAS u32x4*)(bb_ + kdst[i]) = kst[i]; \
        _Pragma("unroll") for (int i = 0; i < NVL; ++i) *(LAS u32x4*)(bb_ + vdst[i]) = vst[i]; } while (0)
    f32x16 o[NDB];
#pragma unroll
    for (int d = 0; d < NDB; ++d)
#pragma unroll
        for (int r = 0; r < 16; ++r) o[d][r] = 0.f;
    float mref = NEGBIG, lsum = 0.f;
    const int kfrag = st * KSOFF + r32 * KSTR + hi * 16;
    const int vfrag = st * VSOFF + (4 * hi + ((lane & 15) >> 2)) * VSTR + ((lane >> 4) & 1) * 32 + (lane & 3) * 8;
    const LAS float* mytab = tab + (MODE == 2 ? st * 512 : 0);
    ATT_ISSUE(t0); ATT_COMMIT(0); __syncthreads();
    for (int t = t0; t < t1; ++t) {
        const int buf = (t - t0) & 1;
        if (t + 1 < t1) ATT_ISSUE(t + 1);
        const LAS unsigned char* kb = lds + buf * BUFB + KOFF + kfrag;
        const LAS unsigned char* vb = lds + buf * BUFB + VOFF + vfrag;
        const int ks = 64 * t;
        bool near = (MODE == 2); float cb = 0.f;
        if (MODE == 0) { const int maxrel = ks + 63 - qslot0, minrel = ks - (qslot0 + 31);
            if (maxrel <= -91) cb = mytab[0]; else if (minrel >= 91) cb = mytab[511]; else near = true; }
        f32x16 p0, p1;
#pragma unroll
        for (int r = 0; r < 16; ++r) { p0[r] = cb; p1[r] = cb; }
#pragma unroll
        for (int kc = 0; kc < NKC; ++kc) {
            const bf16x8 a0 = *(const LAS bf16x8*)(kb + kc * 32), a1 = *(const LAS bf16x8*)(kb + 32 * KSTR + kc * 32);
            p0 = __builtin_amdgcn_mfma_f32_32x32x16_bf16(a0, qf[kc], p0, 0, 0, 0);
            p1 = __builtin_amdgcn_mfma_f32_32x32x16_bf16(a1, qf[kc], p1, 0, 0, 0);
        }
        if (MODE != 1 && near) {
            const int relb = ks + 4 * hi - (qslot0 + r32) + 256;
#pragma unroll
            for (int r = 0; r < 16; ++r) { const int c = (r & 3) + 8 * (r >> 2);
                int i0 = relb + c, i1 = relb + c + 32; i0 = i0 < 0 ? 0 : (i0 > 511 ? 511 : i0); i1 = i1 < 0 ? 0 : (i1 > 511 ? 511 : i1);
                p0[r] += mytab[i0]; p1[r] += mytab[i1]; }
        }
        if (t == 1) {
#pragma unroll
            for (int r = 0; r < 16; ++r) { const int c = (r & 3) + 8 * (r >> 2) + 4 * hi; p0[r] = NEGBIG; if (c < 16) p1[r] = NEGBIG; }
        }
        float mx = fmaxf(p0[0], p1[0]);
#pragma unroll
        for (int r = 1; r < 16; ++r) mx = fmaxf(mx, fmaxf(p0[r], p1[r]));
        mx = swapmax(mx);
        if (__any(mx > mref + 8.0f)) {
            const float mn = fmaxf(mref, mx), f = __builtin_amdgcn_exp2f(mref - mn); mref = mn; lsum *= f;
#pragma unroll
            for (int d = 0; d < NDB; ++d)
#pragma unroll
                for (int r = 0; r < 16; ++r) o[d][r] *= f;
        }
        float ps = 0.f;
#pragma unroll
        for (int r = 0; r < 16; ++r) { p0[r] = __builtin_amdgcn_exp2f(p0[r] - mref); p1[r] = __builtin_amdgcn_exp2f(p1[r] - mref); ps += p0[r] + p1[r]; }
        lsum += ps;
        bf16x8 pk[4];
        { u32x4 w;
          w.x = cvtpk(p0[0], p0[1]); w.y = cvtpk(p0[2], p0[3]); w.z = cvtpk(p0[4], p0[5]); w.w = cvtpk(p0[6], p0[7]); pk[0] = __builtin_bit_cast(bf16x8, w);
          w.x = cvtpk(p0[8], p0[9]); w.y = cvtpk(p0[10], p0[11]); w.z = cvtpk(p0[12], p0[13]); w.w = cvtpk(p0[14], p0[15]); pk[1] = __builtin_bit_cast(bf16x8, w);
          w.x = cvtpk(p1[0], p1[1]); w.y = cvtpk(p1[2], p1[3]); w.z = cvtpk(p1[4], p1[5]); w.w = cvtpk(p1[6], p1[7]); pk[2] = __builtin_bit_cast(bf16x8, w);
          w.x = cvtpk(p1[8], p1[9]); w.y = cvtpk(p1[10], p1[11]); w.z = cvtpk(p1[12], p1[13]); w.w = cvtpk(p1[14], p1[15]); pk[3] = __builtin_bit_cast(bf16x8, w); }
#pragma unroll
        for (int d = 0; d < NDB; ++d)
#pragma unroll
            for (int c = 0; c < 4; ++c) {
                const v4i16_t lo = __builtin_amdgcn_ds_read_tr16_b64_v4i16((LAS v4i16_t*)(vb + c * 16 * VSTR + d * 64));
                const v4i16_t hh = __builtin_amdgcn_ds_read_tr16_b64_v4i16((LAS v4i16_t*)(vb + c * 16 * VSTR + 8 * VSTR + d * 64));
                const bf16x8 vf = (bf16x8){lo[0], lo[1], lo[2], lo[3], hh[0], hh[1], hh[2], hh[3]};
                o[d] = __builtin_amdgcn_mfma_f32_32x32x16_bf16(vf, pk[c], o[d], 0, 0, 0);
            }
        if (t + 1 < t1) ATT_COMMIT(buf ^ 1);
        __syncthreads();
    }
#undef ATT_ISSUE
#undef ATT_COMMIT
    float lt = swapsum(lsum);
    if (MODE == 2) lt += __builtin_amdgcn_exp2f(A.sinks[2 * hx + st] * LOG2E - mref);
    const float inv = 1.0f / lt;
#pragma unroll
    for (int d = 0; d < NDB; ++d)
#pragma unroll
        for (int r = 0; r < 16; ++r) o[d][r] *= inv;
    const size_t orow = row0 + qslot0 + r32;
    if (MODE == 0) {
        LAS float* X = (LAS float*)lds;
        if (st == 1) {
#pragma unroll
            for (int d = 0; d < NDB; ++d)
#pragma unroll
                for (int r = 0; r < 16; ++r) X[(qg * 64 + d * 16 + r) * 64 + lane] = o[d][r];
        }
        __syncthreads();
        if (st == 0) {
            const float sx = wave_sum(A.dl[lane] * A.dl[64 + lane], lane), sy = wave_sum(A.dl[128 + lane] * A.dl[192 + lane], lane);
            const float lam = __expf(sx) - __expf(sy) + A.lam_init;
            float ss = 0.f;
#pragma unroll
            for (int d = 0; d < NDB; ++d)
#pragma unroll
                for (int r = 0; r < 16; ++r) { const float v = o[d][r] - lam * X[(qg * 64 + d * 16 + r) * 64 + lane]; o[d][r] = v; ss += v * v; }
            ss = swapsum(ss);
            const float rs = (1.0f / sqrtf(ss * (1.0f / 128.0f) + EPSN)) * (1.0f - A.lam_init);
            bf16_t* op = A.O + orow * DM + hx * 128 + 4 * hi;
#pragma unroll
            for (int d = 0; d < NDB; ++d)
#pragma unroll
                for (int g4 = 0; g4 < 4; ++g4) {
                    const f32x4 gv = *(const f32x4*)(A.gsub + d * 32 + 8 * g4 + 4 * hi);
                    u32x2 w; w.x = cvtpk(o[d][4 * g4] * rs * gv[0], o[d][4 * g4 + 1] * rs * gv[1]); w.y = cvtpk(o[d][4 * g4 + 2] * rs * gv[2], o[d][4 * g4 + 3] * rs * gv[3]);
                    *(u32x2*)(op + d * 32 + 8 * g4) = w;
                }
        }
    } else {
        bf16_t* op = A.O + orow * DM + (MODE == 1 ? 768 : 512) + (2 * hx + st) * 64 + 4 * hi;
#pragma unroll
        for (int d = 0; d < NDB; ++d)
#pragma unroll
            for (int g4 = 0; g4 < 4; ++g4) {
                u32x2 w; w.x = cvtpk(o[d][4 * g4], o[d][4 * g4 + 1]); w.y = cvtpk(o[d][4 * g4 + 2], o[d][4 * g4 + 3]);
                *(u32x2*)(op + d * 32 + 8 * g4) = w;
            }
    }
    __syncthreads();
}
#ifndef ATT_PF
#define ATT_PF 4
#endif
template <int MODE> __device__ __forceinline__ void attn_unit4(LAS unsigned char* lds, const int uidx, const AttnArgs& A) {
    constexpr int DQK = MODE == 1 ? 96 : 64, DV = MODE == 0 ? 128 : 64;
    constexpr int KCH = MODE == 0 ? 16 : (MODE == 1 ? 24 : 8), VCH = MODE == 2 ? 8 : 16;
    constexpr int KSTR = KCH * 16 + 16, VSTR = 320;
    constexpr int KSOFF = MODE == 0 ? 128 : (MODE == 1 ? 192 : 0), VSOFF = MODE == 1 ? 128 : 0;
    constexpr int NKL = KCH * 64 / NTHR, NVL = VCH * 64 / NTHR;
    constexpr int KSTG = 25600, VBASE = 2 * KSTG, VSTG = 20480, TABOFF = VBASE + 3 * VSTG;
    constexpr int NKC = DQK / 16, NDB = DV / 32;
    int tid = threadIdx.x; asm volatile("" : "+v"(tid));
    float negbig = NEGBIG; asm volatile("" : "+v"(negbig));
    const int lane = tid & 63, wid = __builtin_amdgcn_readfirstlane(tid >> 6), r32 = lane & 31, hi = lane >> 5, qg = wid & 3, st = wid >> 2;
    const int qb = uidx % 65, bh = uidx / 65;
    const int NH = MODE == 0 ? 4 : 2;
    const int b = bh / NH, hx = bh % NH;
    const size_t row0 = (size_t)b * LP;
    const GAS bf16_t *Kg, *Vg, *Qg; int kld, vld;
    if (MODE == 0) { Kg = (const GAS bf16_t*)A.U + 512 + hx * 128; kld = DIN; Vg = (const GAS bf16_t*)A.U + 1024 + hx * 128; vld = DIN; Qg = (const GAS bf16_t*)A.U + hx * 128 + st * 64; }
    else if (MODE == 1) { Kg = (const GAS bf16_t*)A.KC + hx * 192; kld = 384; Vg = (const GAS bf16_t*)A.VC + hx * 128; vld = 256; Qg = (const GAS bf16_t*)A.U + 2048 + (2 * hx + st) * 96; }
    else { Kg = (const GAS bf16_t*)A.U + 1792 + hx * 64; kld = DIN; Vg = (const GAS bf16_t*)A.U + 1920 + hx * 64; vld = DIN; Qg = (const GAS bf16_t*)A.U + 1536 + (2 * hx + st) * 64; }
    int t0 = 1, t1 = 130;
    if (MODE == 2) { t0 = 2 * (qb - 1); if (t0 < 1) t0 = 1; t1 = 2 * (qb + 2); if (t1 > 130) t1 = 130; }
    LAS float* tab = (LAS float*)(lds + TABOFF);
    if (MODE != 1) {
        const int rel = tid - 256; const int bk = t5_bucket_dev(rel);
        if (MODE == 0) { tab[tid] = A.rel_bias[bk * 8 + hx] * LOG2E; }
        else { const bool okw = (rel <= 128 && rel >= -128);
            tab[tid] = okw ? A.rel_bias[bk * 8 + 4 + 2 * hx] * LOG2E : negbig; tab[512 + tid] = okw ? A.rel_bias[bk * 8 + 4 + 2 * hx + 1] * LOG2E : negbig; }
    }
    const int qslot0 = qb * 128 + qg * 32;
    bf16x8 qf[NKC];
    { const GAS bf16_t* qp = Qg + (row0 + qslot0 + r32) * DIN + hi * 8;
#pragma unroll
      for (int kc = 0; kc < NKC; ++kc) qf[kc] = *(const GAS bf16x8*)(qp + kc * 16); }
    int ksrc[NKL], kdst[NKL], vsrc[NVL], vdst[NVL];
#pragma unroll
    for (int i = 0; i < NKL; ++i) { const int id = tid + NTHR * i, key = id / KCH, ch = id % KCH; ksrc[i] = key * kld + ch * 8; kdst[i] = key * KSTR + ch * 16; }
#pragma unroll
    for (int i = 0; i < NVL; ++i) { const int id = tid + NTHR * i, key = id / VCH, ch = id % VCH; vsrc[i] = key * vld + ch * 8; vdst[i] = VBASE + key * VSTR + ch * 16; }
    u32x4 kst[NKL], vst[NVL];
#define A2_ISSUE_K(t) do { int tc_ = (t); tc_ = tc_ < t1 ? tc_ : t1 - 1; const GAS bf16_t* kp_ = Kg + (row0 + 64 * (size_t)tc_) * kld; \
        _Pragma("unroll") for (int i = 0; i < NKL; ++i) kst[i] = *(const GAS u32x4*)(kp_ + ksrc[i]); } while (0)
#define A2_ISSUE_V(t) do { int tc_ = (t); tc_ = tc_ < t1 ? tc_ : t1 - 1; const GAS bf16_t* vp_ = Vg + (row0 + 64 * (size_t)tc_) * vld; \
        _Pragma("unroll") for (int i = 0; i < NVL; ++i) vst[i] = *(const GAS u32x4*)(vp_ + vsrc[i]); } while (0)
#define A2_COMMIT_K(slot) do { LAS unsigned char* bb_ = lds + (slot) * KSTG; _Pragma("unroll") for (int i = 0; i < NKL; ++i) *(LAS u32x4*)(bb_ + kdst[i]) = kst[i]; } while (0)
#define A2_COMMIT_V(slot) do { LAS unsigned char* bb_ = lds + (slot) * VSTG; _Pragma("unroll") for (int i = 0; i < NVL; ++i) *(LAS u32x4*)(bb_ + vdst[i]) = vst[i]; } while (0)
#define A2_TILE_BIAS(t, cbv, nearv) do { cbv = 0.f; nearv = (MODE == 2); if (MODE == 0) { const int ks_ = 64 * (t); const int maxrel_ = ks_ + 63 - qslot0, minrel_ = ks_ - (qslot0 + 31); \
        const bool lf_ = maxrel_ <= -91, rt_ = minrel_ >= 91; cbv = lf_ ? tabL : (rt_ ? tabR : 0.f); nearv = !(lf_ || rt_); } } while (0)
#define A2_QK(S0, S1, slot, cbv) do { const LAS unsigned char* kb_ = lds + (slot) * KSTG + kfrag; \
        _Pragma("unroll") for (int r = 0; r < 16; ++r) { S0[r] = cbv; S1[r] = cbv; } \
        _Pragma("unroll") for (int kc = 0; kc < NKC; ++kc) { const bf16x8 a0_ = *(const LAS bf16x8*)(kb_ + kc * 32), a1_ = *(const LAS bf16x8*)(kb_ + 32 * KSTR + kc * 32); \
            S0 = __builtin_amdgcn_mfma_f32_32x32x16_bf16(a0_, qf[kc], S0, 0, 0, 0); S1 = __builtin_amdgcn_mfma_f32_32x32x16_bf16(a1_, qf[kc], S1, 0, 0, 0); } } while (0)
#define A2_PV(slot, PK) do { const LAS unsigned char* vb_ = lds + VBASE + (slot) * VSTG + vfrag; \
        _Pragma("unroll") for (int d = 0; d < NDB; ++d) _Pragma("unroll") for (int c = 0; c < 4; ++c) { \
            const v4i16_t lo_ = __builtin_amdgcn_ds_read_tr16_b64_v4i16((LAS v4i16_t*)(vb_ + c * 16 * VSTR + d * 64)); \
            const v4i16_t hh_ = __builtin_amdgcn_ds_read_tr16_b64_v4i16((LAS v4i16_t*)(vb_ + c * 16 * VSTR + 8 * VSTR + d * 64)); \
            const bf16x8 vf_ = (bf16x8){lo_[0], lo_[1], lo_[2], lo_[3], hh_[0], hh_[1], hh_[2], hh_[3]}; \
            o[d] = __builtin_amdgcn_mfma_f32_32x32x16_bf16(vf_, __builtin_bit_cast(bf16x8, PK[c]), o[d], 0, 0, 0); } } while (0)
    f32x16 o[NDB];
#pragma unroll
    for (int d = 0; d < NDB; ++d)
#pragma unroll
        for (int r = 0; r < 16; ++r) o[d][r] = 0.f;
    float lsum = 0.f;
    const int kfrag = st * KSOFF + r32 * KSTR + hi * 16;
    const int vfrag = st * VSOFF + (4 * hi + ((lane & 15) >> 2)) * VSTR + ((lane >> 4) & 1) * 32 + (lane & 3) * 8;
    const LAS float* mytab = tab + (MODE == 2 ? st * 512 : 0);
    {
      u32x4 kst2[NKL];
      A2_ISSUE_K(t0); A2_ISSUE_V(t0);
      { const GAS bf16_t* kp_ = Kg + (row0 + 64 * (size_t)(t0 + 1)) * kld;
#pragma unroll
        for (int i = 0; i < NKL; ++i) kst2[i] = *(const GAS u32x4*)(kp_ + ksrc[i]); }
      A2_COMMIT_K(t0 & 1); A2_COMMIT_V(0);
      { LAS unsigned char* bb_ = lds + ((t0 + 1) & 1) * KSTG;
#pragma unroll
        for (int i = 0; i < NKL; ++i) *(LAS u32x4*)(bb_ + kdst[i]) = kst2[i]; } }
    __syncthreads();
    float tabL = 0.f, tabR = 0.f; if (MODE == 0) { tabL = mytab[0]; tabR = mytab[511]; }
    f32x16 s0, s1, n0, n1; u32x4 pk[4]; float fprev = 1.0f, fcur = 1.0f;
#define A4_BIAS(t, SA, SB) do { \
        const int relb = 64 * (t) + 4 * hi - (qslot0 + r32) + 256; \
        _Pragma("unroll") for (int r = 0; r < 16; ++r) { const int c = (r & 3) + 8 * (r >> 2); \
            int i0 = relb + c, i1 = relb + c + 32; i0 = i0 < 0 ? 0 : (i0 > 511 ? 511 : i0); i1 = i1 < 0 ? 0 : (i1 > 511 ? 511 : i1); \
            SA[r] += mytab[i0]; SB[r] += mytab[i1]; } } while (0)
    float cbc; bool nearc;
    A2_TILE_BIAS(t0, cbc, nearc);
    { const float zero_ = 0.f; A2_QK(s0, s1, t0 & 1, zero_); }
    __syncthreads();
    if (MODE != 1 && nearc) A4_BIAS(t0, s0, s1);
    if (t0 == 1) {
#pragma unroll
        for (int r = 0; r < 16; ++r) { const int c = (r & 3) + 8 * (r >> 2) + 4 * hi; s0[r] = negbig; if (c < 16) s1[r] = negbig; }
    }
    float mref;
    { float mx = fmaxf(s0[0], s1[0]);
#pragma unroll
      for (int r = 1; r < 16; ++r) mx = fmaxf(mx, fmaxf(s0[r], s1[r]));
      mx = swapmax(mx) + cbc; mref = fmaxf(mx, -30.0f);
      const float sh = cbc - mref;
#pragma unroll
      for (int r = 0; r < 16; ++r) { s0[r] += sh; s1[r] += sh; } }
    constexpr bool USE_NEGC = (MODE != 0);
    f32x16 negc;
    { float cb1; bool nr1; A2_TILE_BIAS(t0 + 1, cb1, nr1); const float nv = cb1 - mref;
#pragma unroll
      for (int r = 0; r < 16; ++r) { n0[r] = nv; n1[r] = nv; negc[r] = nv; } }
    int vs_prev = 2, vs_cur = 0, vs_next = 1;
#pragma unroll
    for (int c = 0; c < 4; ++c) pk[c] = (u32x4){0u, 0u, 0u, 0u};
    bf16x8 fan[ATT_PF];
    constexpr int NM = 2 * NKC + 4 * NDB;
    constexpr int EPS = (MODE == 2) ? 4 : 2;
    constexpr int PF = ATT_PF;
    constexpr int NPV = 4 * NDB;
    constexpr int GE = 8 / EPS;
    constexpr int GSTEP = GE > NDB ? GE : NDB;
    constexpr int GF = (MODE == 0) ? 4 : 2;
    static_assert(PF <= NPV, "prefetch");
#define A3_LOADF(i) do { if ((i) >= NPV) { const int j_ = (i) - NPV; fa[(i)] = *(const LAS bf16x8*)(kb_ + (j_ & 1) * 32 * KSTR + (j_ >> 1) * 32); } \
            else { const int c_ = (i) / NDB, d_ = (i) % NDB; \
                const v4i16_t lo_ = __builtin_amdgcn_ds_read_tr16_b64_v4i16((LAS v4i16_t*)(vb_ + c_ * 16 * VSTR + d_ * 64)); \
                const v4i16_t hh_ = __builtin_amdgcn_ds_read_tr16_b64_v4i16((LAS v4i16_t*)(vb_ + c_ * 16 * VSTR + 8 * VSTR + d_ * 64)); \
                fa[(i)] = (bf16x8){lo_[0], lo_[1], lo_[2], lo_[3], hh_[0], hh_[1], hh_[2], hh_[3]}; } } while (0)
#define A3_BODY(t, SC0, SC1, SN0, SN1) do { \
        if (__any(fprev != 1.0f)) { \
            _Pragma("unroll") for (int d = 0; d < NDB; ++d) _Pragma("unroll") for (int r = 0; r < 16; ++r) o[d][r] *= fprev; } \
        float cb1_, cb2_; bool nr1_, nr2_; \
        A2_TILE_BIAS((t) + 1, cb1_, nr1_); A2_TILE_BIAS((t) + 2, cb2_, nr2_); \
        const float nvn_ = cb2_ - mref;                         \
        const LAS unsigned char* kb_ = lds + (((t) + 1) & 1) * KSTG + kfrag; \
        const LAS unsigned char* vb_ = lds + VBASE + (((t) > t0) ? vs_prev : vs_cur) * VSTG + vfrag; \
        bf16x8 fa[NM]; \
        _Pragma("unroll") for (int i = 0; i < PF; ++i) fa[i] = fan[i]; \
        float ps = 0.f, eprev = 0.f; \
        __builtin_amdgcn_sched_barrier(0); \
        _Pragma("unroll") for (int i = 0; i < NM; ++i) { \
            if (i + PF < NM) A3_LOADF(i + PF); \
            if (i < NPV) { const int c = i / NDB, d = i % NDB; o[d] = __builtin_amdgcn_mfma_f32_32x32x16_bf16(fa[i], __builtin_bit_cast(bf16x8, pk[c]), o[d], 0, 0, 0); } \
            else { const int j = i - NPV; if (j & 1) SN1 = __builtin_amdgcn_mfma_f32_32x32x16_bf16(fa[i], qf[j >> 1], (USE_NEGC && j == 1) ? negc : SN1, 0, 0, 0); \
                                          else SN0 = __builtin_amdgcn_mfma_f32_32x32x16_bf16(fa[i], qf[j >> 1], (USE_NEGC && j == 0) ? negc : SN0, 0, 0, 0); } \
            _Pragma("unroll") for (int e = 0; e < 32; ++e) { \
                if (NDB + (e * (NM - NDB)) / 32 == i) { \
                    const float ev = __builtin_amdgcn_exp2f(e < 16 ? SC0[e & 15] : SC1[e & 15]); ps += ev; \
                    if (e & 1) pk[e >> 3][(e >> 1) & 3] = cvtpk(eprev, ev); else eprev = ev; } } \
            if (i == 1) A2_ISSUE_K((t) + 2); \
            if (i == 2) A2_ISSUE_V((t) + 1); \
            if (i == NM - 4) A2_COMMIT_K((t) & 1); \
            if (i == NM - 2) A2_COMMIT_V(vs_next); \
            __builtin_amdgcn_sched_barrier(0); \
        } \
        asm volatile("" :: "v"(pk[0]), "v"(pk[1]), "v"(pk[2]), "v"(pk[3]), "v"(ps)); \
        if (!USE_NEGC) { _Pragma("unroll") for (int r = 0; r < 16; ++r) { SC0[r] = nvn_; SC1[r] = nvn_; } } \
        { const LAS unsigned char* vbn_ = lds + VBASE + vs_cur * VSTG + vfrag;        \
          _Pragma("unroll") for (int i = 0; i < PF; ++i) { const int c_ = i / NDB, d_ = i % NDB; \
            const v4i16_t lo_ = __builtin_amdgcn_ds_read_tr16_b64_v4i16((LAS v4i16_t*)(vbn_ + c_ * 16 * VSTR + d_ * 64)); \
            const v4i16_t hh_ = __builtin_amdgcn_ds_read_tr16_b64_v4i16((LAS v4i16_t*)(vbn_ + c_ * 16 * VSTR + 8 * VSTR + d_ * 64)); \
            fan[i] = (bf16x8){lo_[0], lo_[1], lo_[2], lo_[3], hh_[0], hh_[1], hh_[2], hh_[3]}; } } \
        lsum = lsum * fcur + ps; \
        fprev = fcur; fcur = 1.0f; \
          \
        if (MODE != 1 && nr1_) A4_BIAS((t) + 1, SN0, SN1); \
        if ((t) + 1 < t1 && __any(ps > 1.0e12f)) { float dl = ps > 1.0e12f ? floorf(__builtin_amdgcn_logf(ps)) : 0.f; dl = swapmax(dl); \
            mref += dl; fcur = __builtin_amdgcn_exp2f(-dl); const float nv2_ = cb2_ - mref; \
            _Pragma("unroll") for (int r = 0; r < 16; ++r) { SN0[r] -= dl; SN1[r] -= dl; SC0[r] = nv2_; SC1[r] = nv2_; negc[r] = nv2_; } } \
        __syncthreads(); \
        { const int tmp = vs_prev; vs_prev = vs_cur; vs_cur = vs_next; vs_next = tmp; } \
    } while (0)
    { const LAS unsigned char* vb_ = lds + VBASE + vs_cur * VSTG + vfrag; const LAS unsigned char* kb_ = lds; bf16x8 fa[NM];
#pragma unroll
      for (int i = 0; i < PF; ++i) { A3_LOADF(i); fan[i] = fa[i]; } }
    if (wid >= 4) __builtin_amdgcn_s_setprio(1);
    int t = t0;
    for (; t + 1 < t1; t += 2) {
        A3_BODY(t, s0, s1, n0, n1);
        A3_BODY(t + 1, n0, n1, s0, s1);
    }
    if (t < t1) { A3_BODY(t, s0, s1, n0, n1); }
#undef A3_BODY
#undef A3_LOADF
#undef A4_BIAS
    if (__any(fprev != 1.0f)) {
#pragma unroll
        for (int d = 0; d < NDB; ++d)
#pragma unroll
            for (int r = 0; r < 16; ++r) o[d][r] *= fprev;
    }
    __builtin_amdgcn_s_setprio(0);
    A2_PV(vs_prev, pk);
    __syncthreads();
#undef A2_ISSUE_K
#undef A2_ISSUE_V
#undef A2_COMMIT_K
#undef A2_COMMIT_V
#undef A2_TILE_BIAS
#undef A2_QK
#undef A2_PV
    float lt = swapsum(lsum);
    if (MODE == 2) lt += __builtin_amdgcn_exp2f(A.sinks[2 * hx + st] * LOG2E - mref);
    const float inv = 1.0f / lt;
#pragma unroll
    for (int d = 0; d < NDB; ++d)
#pragma unroll
        for (int r = 0; r < 16; ++r) o[d][r] *= inv;
    const size_t orow = row0 + qslot0 + r32;
    if (MODE == 0) {
        LAS float* X = (LAS float*)lds;
        if (st == 1) {
#pragma unroll
            for (int d = 0; d < NDB; ++d)
#pragma unroll
                for (int r = 0; r < 16; ++r) X[(qg * 64 + d * 16 + r) * 64 + lane] = o[d][r];
        }
        __syncthreads();
        if (st == 0) {
            const float sx = wave_sum(A.dl[lane] * A.dl[64 + lane], lane), sy = wave_sum(A.dl[128 + lane] * A.dl[192 + lane], lane);
            const float lam = __expf(sx) - __expf(sy) + A.lam_init;
            float ss = 0.f;
#pragma unroll
            for (int d = 0; d < NDB; ++d)
#pragma unroll
                for (int r = 0; r < 16; ++r) { const float v = o[d][r] - lam * X[(qg * 64 + d * 16 + r) * 64 + lane]; o[d][r] = v; ss += v * v; }
            ss = swapsum(ss);
            const float rs = (1.0f / sqrtf(ss * (1.0f / 128.0f) + EPSN)) * (1.0f - A.lam_init);
            GAS bf16_t* op = (GAS bf16_t*)A.O + orow * DM + hx * 128 + 4 * hi;
#pragma unroll
            for (int d = 0; d < NDB; ++d)
#pragma unroll
                for (int g4 = 0; g4 < 4; ++g4) {
                    const f32x4 gv = *(const GAS f32x4*)((const GAS float*)A.gsub + d * 32 + 8 * g4 + 4 * hi);
                    u32x2 w; w.x = cvtpk(o[d][4 * g4] * rs * gv[0], o[d][4 * g4 + 1] * rs * gv[1]); w.y = cvtpk(o[d][4 * g4 + 2] * rs * gv[2], o[d][4 * g4 + 3] * rs * gv[3]);
                    *(GAS u32x2*)(op + d * 32 + 8 * g4) = w;
                }
        }
    } else {
        GAS bf16_t* op = (GAS bf16_t*)A.O + orow * DM + (MODE == 1 ? 768 : 512) + (2 * hx + st) * 64 + 4 * hi;
#pragma unroll
        for (int d = 0; d < NDB; ++d)
#pragma unroll
            for (int g4 = 0; g4 < 4; ++g4) {
                u32x2 w; w.x = cvtpk(o[d][4 * g4], o[d][4 * g4 + 1]); w.y = cvtpk(o[d][4 * g4 + 2], o[d][4 * g4 + 3]);
                *(GAS u32x2*)(op + d * 32 + 8 * g4) = w;
            }
    }
    __syncthreads();
}
__device__ __forceinline__ void norm_rows(float* LEAD, float* OUT, const float* gain, bf16_t* XN, int gw, int ngw) {
    int lane = threadIdx.x; asm volatile("" : "+v"(lane)); lane &= 63; asm volatile("" : "+s"(ngw), "+s"(gw));
    f32x4 g[4];
#pragma unroll
    for (int j = 0; j < 4; ++j) g[j] = ((const f32x4*)gain)[lane + 64 * j];
    for (int r = gw; r < MROWS; r += ngw) {
        const f32x4* hp = (const f32x4*)hrow(LEAD, OUT, r) + lane;
        f32x4 v[4]; float s = 0.f;
#pragma unroll
        for (int j = 0; j < 4; ++j) { v[j] = hp[64 * j]; s += (v[j].x * v[j].x + v[j].y * v[j].y) + (v[j].z * v[j].z + v[j].w * v[j].w); }
        const float rstd = 1.0f / sqrtf(wave_sum(s, lane) * (1.0f / DM) + EPSN);
        u32x2* o8 = (u32x2*)(XN + (size_t)r * DM) + lane;
#pragma unroll
        for (int j = 0; j < 4; ++j) { const f32x4 y = v[j] * rstd * g[j]; u32x2 w; w.x = pk2(y.x, y.y); w.y = pk2(y.z, y.w); o8[64 * j] = w; }
    }
}
__device__ __forceinline__ void final_rows(float* OUT, const float* gain, int gw, int ngw) {
    int lane = threadIdx.x; asm volatile("" : "+v"(lane)); lane &= 63; asm volatile("" : "+s"(ngw), "+s"(gw));
    f32x4 g[4];
#pragma unroll
    for (int j = 0; j < 4; ++j) g[j] = ((const f32x4*)gain)[lane + 64 * j];
    for (int r = gw; r < NSEQ * SEQ; r += ngw) {
        f32x4* hp = (f32x4*)(OUT + (size_t)r * DM) + lane;
        f32x4 v[4]; float s = 0.f;
#pragma unroll
        for (int j = 0; j < 4; ++j) { v[j] = hp[64 * j]; s += (v[j].x * v[j].x + v[j].y * v[j].y) + (v[j].z * v[j].z + v[j].w * v[j].w); }
        const float rstd = 1.0f / sqrtf(wave_sum(s, lane) * (1.0f / DM) + EPSN);
#pragma unroll
        for (int j = 0; j < 4; ++j) hp[64 * j] = v[j] * rstd * g[j];
    }
}
__device__ __forceinline__ void init_rows(const float* xp, const float* xs, const float* meta, float* LEAD, float* OUT, const float* gain, bf16_t* XN, float* SS, int gw, int ngw) {
    int lane = threadIdx.x; asm volatile("" : "+v"(lane)); lane &= 63; asm volatile("" : "+s"(ngw), "+s"(gw));
    f32x4 g[4];
#pragma unroll
    for (int j = 0; j < 4; ++j) g[j] = ((const f32x4*)gain)[lane + 64 * j];
    for (int r = gw; r < MROWS; r += ngw) {
        const int b = r / LP, s = r - b * LP;
        f32x4 v[4];
        if (s < 112) {
#pragma unroll
            for (int j = 0; j < 4; ++j) v[j] = (f32x4){0.f, 0.f, 0.f, 0.f};
        } else {
            const float* src = s < 128 ? meta + (size_t)(s - 112) * DM : (b < 2 ? xp + ((size_t)b * SEQ + (s - 128)) * DM : xs + ((size_t)(b - 2) * SEQ + (s - 128)) * DM);
#pragma unroll
            for (int j = 0; j < 4; ++j) v[j] = ((const f32x4*)src)[lane + 64 * j];
        }
        float sq = 0.f;
#pragma unroll
        for (int j = 0; j < 4; ++j) sq += (v[j].x * v[j].x + v[j].y * v[j].y) + (v[j].z * v[j].z + v[j].w * v[j].w);
        sq = wave_sum(sq, lane);
        if (lane == 0) SS[r] = sq;
        f32x4* hp = (f32x4*)hrow(LEAD, OUT, r) + lane;
        u32x2* o8 = (u32x2*)(XN + (size_t)r * DM) + lane;
#pragma unroll
        for (int j = 0; j < 4; ++j) { if (s < 128) hp[64 * j] = v[j]; const f32x4 y = v[j] * g[j]; u32x2 w; w.x = pk2(y.x, y.y); w.y = pk2(y.z, y.w); o8[64 * j] = w; }
    }
}
__device__ __forceinline__ void mla_rows(const bf16_t* U, const float* gcq, const float* gckv, const float* rope, bf16_t* XQ, bf16_t* XKV, bf16_t* KC, int gw, int ngw) {
    int lane = threadIdx.x; asm volatile("" : "+v"(lane)); lane &= 63; asm volatile("" : "+s"(ngw), "+s"(gw));
    const f32x4 gq = ((const f32x4*)gcq)[lane];
    const float gk0 = gckv[2 * lane], gk1 = gckv[2 * lane + 1];
    for (int r0 = gw; r0 < MROWS; r0 += 2 * ngw) {
        u32x2 cq[2]; unsigned ckv[2]; float krv[2], cs[2], sn[2]; int rr[2];
#pragma unroll
        for (int k = 0; k < 2; ++k) { int r = r0 + k * ngw; r = r < MROWS ? r : r0; rr[k] = r;
            const bf16_t* up = U + (size_t)r * DIN + 2048;
            cq[k] = *(const u32x2*)(up + 4 * lane); ckv[k] = *(const unsigned*)(up + 256 + 2 * lane); krv[k] = bf2f(up[384 + (lane & 31)]);
            const int s = r % LP, j = lane & 15; cs[k] = rope[(size_t)s * 32 + j]; sn[k] = rope[(size_t)s * 32 + 16 + j]; }
#pragma unroll
        for (int k = 0; k < 2; ++k) {
            if (k == 1 && r0 + ngw >= MROWS) break;
            const int r = rr[k];
            const float q0 = __builtin_bit_cast(float, cq[k].x << 16), q1 = __builtin_bit_cast(float, cq[k].x & 0xffff0000u), q2 = __builtin_bit_cast(float, cq[k].y << 16), q3 = __builtin_bit_cast(float, cq[k].y & 0xffff0000u);
            const float k0 = __builtin_bit_cast(float, ckv[k] << 16), k1 = __builtin_bit_cast(float, ckv[k] & 0xffff0000u);
            const float sq = wave_sum((q0 * q0 + q1 * q1) + (q2 * q2 + q3 * q3), lane), sk = wave_sum(k0 * k0 + k1 * k1, lane);
            const float rq = 1.0f / sqrtf(sq * (1.0f / 256.0f) + EPSN), rk = 1.0f / sqrtf(sk * (1.0f / 128.0f) + EPSN);
            u32x2 wq; wq.x = pk2(q0 * rq * gq.x, q1 * rq * gq.y); wq.y = pk2(q2 * rq * gq.z, q3 * rq * gq.w);
            *(u32x2*)(XQ + (size_t)r * 256 + 4 * lane) = wq;
            *(unsigned*)(XKV + (size_t)r * 128 + 2 * lane) = pk2(k0 * rk * gk0, k1 * rk * gk1);
            const float other = lane_xor(krv[k], lane, 16);
            const float ro = (lane & 16) ? (krv[k] * cs[k] + other * sn[k]) : (krv[k] * cs[k] - other * sn[k]);
            if (lane < 32) { const unsigned short ob = (unsigned short)f2bf(ro); bf16_t* kc = KC + (size_t)r * 384 + 64 + lane;
                kc[0] = ob; kc[96] = ob; kc[192] = ob; kc[288] = ob; }
        }
    }
}
#ifndef ATTN_FN
#define ATTN_FN attn_unit4
#endif
#ifndef REP_ATTN
#define REP_ATTN 1
#endif
#ifndef REP_GU
#define REP_GU 1
#endif
#define XB_TMO      128
#define XB_XCNT(j)  (256  + 64 * (j))
#define XB_XSUB(j)  (1280 + 64 * (j))
#define XB_XGEN(j)  (2304 + 64 * (j))
#define XB_TOP      3328
#define XB_TOPGEN   3392
#define XCD_BAR_WORDS 3456
#define XB_SPIN_CAP (1u << 18)

__device__ __forceinline__ unsigned xb_ld(unsigned* p)              { return __hip_atomic_load(p, __ATOMIC_RELAXED, __HIP_MEMORY_SCOPE_AGENT); }
__device__ __forceinline__ unsigned xb_add(unsigned* p, unsigned v) { return __hip_atomic_fetch_add(p, v, __ATOMIC_RELAXED, __HIP_MEMORY_SCOPE_AGENT); }
__device__ __forceinline__ unsigned xb_xcc_id() { return (unsigned)__builtin_amdgcn_s_getreg((3 << 11) | 20) & 0xFu; }
#define XB_SPIN(cond, bar) do { unsigned _sp = 0; while (cond) { __builtin_amdgcn_s_sleep(1); \
    if ((++_sp & 255u) == 0u) { if (xb_ld(&(bar)[XB_TMO])) break; if (_sp > XB_SPIN_CAP) { atomicAdd(&(bar)[XB_TMO], 1u); break; } } } } while (0)

struct XcdBarrier {
    unsigned* bar; unsigned x;
    volatile LAS unsigned* st;
};

__device__ __forceinline__ XcdBarrier xcd_barrier_post(unsigned* bar, volatile LAS unsigned* st) {
    XcdBarrier b; b.bar = bar; b.x = xb_xcc_id(); b.st = st;
    if (threadIdx.x == 0) (void)xb_add(&bar[XB_XCNT(b.x)], 1u);
    return b;
}
__device__ __forceinline__ void xcd_barrier_complete(unsigned* bar, unsigned x, unsigned& nloc, unsigned& nx) {
    const unsigned G = gridDim.x * gridDim.y * gridDim.z;
    unsigned sum, cnt, mine, sp = 0u;
    for (;;) {
        sum = 0u; cnt = 0u; mine = 0u;
#pragma unroll
        for (unsigned j = 0; j < 16; ++j) { const unsigned c = xb_ld(&bar[XB_XCNT(j)]); sum += c; cnt += (c > 0u) ? 1u : 0u; mine = (j == x) ? c : mine; }
        if (sum == G) break;
        __builtin_amdgcn_s_sleep(1);
        if ((++sp & 255u) == 0u) { if (xb_ld(&bar[XB_TMO])) break; if (sp > XB_SPIN_CAP) { atomicAdd(&bar[XB_TMO], 1u); break; } }
    }
    nloc = mine > 0u ? mine : 1u; nx = cnt > 0u ? cnt : 1u;
}

__device__ __forceinline__ void xcd_barrier(const XcdBarrier& b) {
    asm volatile("s_waitcnt vmcnt(0)" ::: "memory");
    __syncthreads();
    if (threadIdx.x == 0) {
        unsigned* bar = b.bar;
        __builtin_amdgcn_s_waitcnt(0);
        unsigned nloc = b.st[0], nx = b.st[1];
        if (nloc == 0u) { xcd_barrier_complete(bar, b.x, nloc, nx); b.st[0] = nloc; b.st[1] = nx; }
        const unsigned old = xb_add(&bar[XB_XSUB(b.x)], 1u);
        const unsigned gen = old / nloc;
        if (old + 1u == (gen + 1u) * nloc) {
            __builtin_amdgcn_fence(__ATOMIC_RELEASE, "agent");
            asm volatile("s_waitcnt vmcnt(0)" ::: "memory");
            const unsigned og = xb_add(&bar[XB_TOP], 1u);
            const unsigned tg = og / nx;
            if (og + 1u == (tg + 1u) * nx) xb_add(&bar[XB_TOPGEN], 1u);
            else XB_SPIN(xb_ld(&bar[XB_TOPGEN]) == tg, bar);
            __builtin_amdgcn_fence(__ATOMIC_ACQUIRE, "agent");
            xb_add(&bar[XB_XGEN(b.x)], 1u);
            asm volatile("s_waitcnt vmcnt(0)" ::: "memory");
        } else {
            XB_SPIN(xb_ld(&bar[XB_XGEN(b.x)]) == gen, bar);
            __builtin_amdgcn_fence(__ATOMIC_ACQUIRE, "agent");
            asm volatile("s_waitcnt vmcnt(0)" ::: "memory");
        }
    }
    __syncthreads();
}


constexpr int CW_BAR = 4096, CW_QUEUE = 64;
constexpr size_t CTL_ZERO_BYTES = 32768;
constexpr int MISC_OFF = 131072 + 320;
constexpr int I_GU = 16 * 176, I_D = 44 * 32, I_IN = 16 * 77, I_UQ = 4 * 12, I_UKV = 2 * 16, I_OUT = 16 * 32;
constexpr int I_LAYER = 2 * I_GU + 2 * I_D + I_IN + I_UQ + I_UKV + I_OUT;

struct KArgs { const float* in[21]; float* out; unsigned char* ws; float inv[16]; };

__global__ void __launch_bounds__(NTHR, 2) mega_fwd(KArgs a) {
    extern __shared__ __attribute__((aligned(16))) unsigned char lds_raw[];
    LAS unsigned char* lds = (LAS unsigned char*)lds_raw;
    cg::grid_group grid = cg::this_grid();
    const int wave = __builtin_amdgcn_readfirstlane(threadIdx.x >> 6);
    const int G = gridDim.x, bx = blockIdx.x;
    const int vcu = (G % 8 == 0) ? (bx % 8) * (G / 8) + bx / 8 : bx;
    const int gw = vcu * NWAVES + wave, ngw = G * NWAVES;
    unsigned char* const ws0 = a.ws;
    volatile LAS unsigned* MISC = (volatile LAS unsigned*)(lds + MISC_OFF);
    if (threadIdx.x < 32) MISC[threadIdx.x] = 0u;
    __syncthreads();
    (void)xcd_barrier_post((unsigned*)ws0 + CW_BAR, MISC + 8);
#define GRID_BAR() do { XcdBarrier xb_; xb_.bar = (unsigned*)ws0 + CW_BAR; xb_.x = xb_xcc_id(); xb_.st = (volatile LAS unsigned*)(lds + MISC_OFF) + 8; xcd_barrier(xb_); } while (0)

    {
        unsigned char* ws = ws0; float* LEAD = (float*)(ws + WS_LEAD); float* ROPE = (float*)(ws + WS_ROPE); float* OUT = a.out; bf16_t* XN = (bf16_t*)(ws + WS_XN);
        int tid = threadIdx.x; asm volatile("" : "+v"(tid)); const int lane = tid & 63;
        LAS float* scr = (LAS float*)(lds + wave * 16384);
#define CONVERT_ITEM(it_) do { const int it = (it_); \
            const int l = it / I_LAYER; int r = it - l * I_LAYER; \
            unsigned char* wl = ws + WS_W + (size_t)l * W_LAYER; \
            if (r < I_GU) { transpose_matrix_item<true>(a.in[5] + (size_t)l * 1024 * 5632, 1024, 5632, (bf16_t*)(wl + W_GU1), r, scr, lane); break; } r -= I_GU; \
            if (r < I_D) { transpose_matrix_item<false>(a.in[6] + (size_t)l * 2816 * 1024, 2816, 1024, (bf16_t*)(wl + W_D1), r, scr, lane); break; } r -= I_D; \
            if (r < I_IN) { transpose_matrix_item<false>(a.in[8] + (size_t)l * 1024 * DIN, 1024, DIN, (bf16_t*)(wl + W_IN), r, scr, lane); break; } r -= I_IN; \
            if (r < I_UQ) { transpose_matrix_item<false>(a.in[14] + (size_t)l * 256 * 384, 256, 384, (bf16_t*)(wl + W_UQ), r, scr, lane); break; } r -= I_UQ; \
            if (r < I_UKV) { transpose_matrix_item<false>(a.in[15] + (size_t)l * 128 * 512, 128, 512, (bf16_t*)(wl + W_UKV), r, scr, lane); break; } r -= I_UKV; \
            if (r < I_OUT) { transpose_matrix_item<false>(a.in[16] + (size_t)l * 1024 * 1024, 1024, 1024, (bf16_t*)(wl + W_OUT), r, scr, lane); break; } r -= I_OUT; \
            if (r < I_GU) { transpose_matrix_item<true>(a.in[18] + (size_t)l * 1024 * 5632, 1024, 5632, (bf16_t*)(wl + W_GU2), r, scr, lane); break; } r -= I_GU; \
            transpose_matrix_item<false>(a.in[19] + (size_t)l * 2816 * 1024, 2816, 1024, (bf16_t*)(wl + W_D2), r, scr, lane); \
         \
    } while (0)
        for (int it_ = gw; it_ < I_LAYER; it_ += ngw) CONVERT_ITEM(it_);
        const int gt = vcu * NTHR + tid, ngt = G * NTHR;
        for (int l = 0; l < 2; ++l) {
            u32x4* pin = (u32x4*)(ws + WS_W + (size_t)l * W_LAYER + W_IN + (size_t)DIN * 1024 * 2);
            for (int i = gt; i < 96 * 1024 * 2 / 16; i += ngt) pin[i] = (u32x4){0u, 0u, 0u, 0u};
            u32x4* puq = (u32x4*)(ws + WS_W + (size_t)l * W_LAYER + W_UQ + (size_t)384 * 256 * 2);
            for (int i = gt; i < 128 * 256 * 2 / 16; i += ngt) puq[i] = (u32x4){0u, 0u, 0u, 0u};
        }
        for (int i = gt; i < LP * 16; i += ngt) {
            const int s = i >> 4, j = i & 15;
            const float ang = (float)(s - 112) * a.inv[j];
            const double ad = (double)ang, kk = rint(ad * 0.15915494309189535);
            const float red = (float)(ad - kk * 6.283185307179586);
            ROPE[(size_t)s * 32 + j] = __cosf(red); ROPE[(size_t)s * 32 + 16 + j] = __sinf(red);
        }
        init_rows(a.in[0], a.in[1], a.in[2], LEAD, OUT, a.in[4], XN, (float*)(ws + WS_SS), gw, ngw);
    }
    if (a.ws == nullptr) grid.sync();
    GRID_BAR();

    int cons = 0;
#pragma unroll 1
    for (int i = 0; i < 4; ++i) {
        const int l = i >> 1;
        unsigned char* ws = ws0; asm volatile("" : "+s"(ws));
        float* LEAD = (float*)(ws + WS_LEAD); float* ROPE = (float*)(ws + WS_ROPE); float* OUT = a.out;
        bf16_t* XN = (bf16_t*)(ws + WS_XN); bf16_t* XQ = (bf16_t*)(ws + WS_XN + XQ_OFF); bf16_t* XKV = (bf16_t*)(ws + WS_XN + XKV_OFF);
        bf16_t* ACT = (bf16_t*)(ws + WS_BIG); bf16_t* U = (bf16_t*)(ws + WS_BIG + U_OFF); bf16_t* KC = (bf16_t*)(ws + WS_BIG + KC_OFF); bf16_t* VC = (bf16_t*)(ws + WS_BIG + VC_OFF);
        float* SSb = (float*)(ws + WS_SS);
        unsigned char* wl = ws + WS_W + (size_t)l * W_LAYER;
        {
            float* ssz = SSb + (size_t)((cons + 1) & 1) * MROWS; int t_ = threadIdx.x; asm volatile("" : "+v"(t_));
            { int st_ = G * NTHR; asm volatile("" : "+s"(st_)); float z_ = 0.f; asm volatile("" : "+v"(z_));
_Pragma("clang loop vectorize(disable) interleave(disable)")
              for (int r = vcu * NTHR + t_; r < MROWS; r += st_) ssz[r] = z_; }
            pg8::Gemm g{XN, (const bf16_t*)(wl + ((i & 1) ? W_GU2 : W_GU1)), MROWS, 5632, 1024}; pg8::StaticOrder S; S.init(MROWS, 5632, G, bx);
            pg8::EpiSwiGLU E{ACT, DFF, SSb + (size_t)(cons & 1) * MROWS};
            for (int rep_ = 0; rep_ < REP_GU; ++rep_) pg8::gemm_phase<pg8::EpiSwiGLU, pg8::StaticOrder, true, true>(lds, g, S, E);
        }
        GRID_BAR();
        {
            const float* gnext = (i & 1) ? ((i == 3) ? a.in[20] : a.in[4] + (size_t)(l + 1) * DM) : a.in[7] + (size_t)l * DM;
            pg8::Gemm g{ACT, (const bf16_t*)(wl + ((i & 1) ? W_D2 : W_D1)), MROWS, 1024, DFF}; pg8::StaticOrder S; S.init(MROWS, 1024, G, bx);
            if (i == 3) {
                pg8::EpiResidLast E{LEAD, OUT, 0.5f, XN, gnext, SSb + (size_t)((cons + 1) & 1) * MROWS, nullptr, nullptr};
                pg8::gemm_phase<pg8::EpiResidLast, pg8::StaticOrder, true, true>(lds, g, S, E);
            } else {
            pg8::EpiResid E{LEAD, OUT, 0.5f, XN, gnext, SSb + (size_t)((cons + 1) & 1) * MROWS, i == 0 ? a.in[0] : (const float*)nullptr, i == 0 ? a.in[1] : (const float*)nullptr};
            pg8::gemm_phase<pg8::EpiResid, pg8::StaticOrder, true, true>(lds, g, S, E);
            }
        }
        if (i == 0 && bx >= 20) {
            int tid = threadIdx.x; asm volatile("" : "+v"(tid)); const int lane = tid & 63;
            LAS float* scr = (LAS float*)(lds + wave * 16384);
            for (int it_ = I_LAYER + (bx - 20) * NWAVES + wave; it_ < 2 * I_LAYER; it_ += (G - 20) * NWAVES) CONVERT_ITEM(it_);
        }
        ++cons;
        GRID_BAR();
        if (i == 3) { final_rows(OUT, a.in[20], gw, ngw); break; }
        if (i & 1) continue;
        {
            float* ssz = SSb + (size_t)((cons + 1) & 1) * MROWS; int t_ = threadIdx.x; asm volatile("" : "+v"(t_));
            { int st_ = G * NTHR; asm volatile("" : "+s"(st_)); float z_ = 0.f; asm volatile("" : "+v"(z_));
_Pragma("clang loop vectorize(disable) interleave(disable)")
              for (int r = vcu * NTHR + t_; r < MROWS; r += st_) ssz[r] = z_; }
            pg8::Gemm g{XN, (const bf16_t*)(wl + W_IN), MROWS, DINP, 1024}; pg8::StaticOrder S; S.init(MROWS, DINP, G, bx);
            pg8::EpiU E{U, 0.125f * LOG2E, SSb + (size_t)(cons & 1) * MROWS};
            pg8::gemm_phase<pg8::EpiU, pg8::StaticOrder, true, true>(lds, g, S, E);
        }
        GRID_BAR();
        mla_rows(U, a.in[12] + (size_t)l * 256, a.in[13] + (size_t)l * 128, ROPE, XQ, XKV, KC, gw, ngw);
        GRID_BAR();
        {
            int kq = 256; asm volatile("" : "+s"(kq));
            pg8::Gemm g{XQ, (const bf16_t*)(wl + W_UQ), MROWS, 512, kq}; pg8::StaticOrder S; S.init(MROWS, 512, G, bx);
            pg8::EpiQC E{U, ROPE, 0.10206207261596575f * LOG2E};
            pg8::gemm_phase<pg8::EpiQC, pg8::StaticOrder, true, true>(lds, g, S, E);
        }
        {
            int kkv = 128; asm volatile("" : "+s"(kkv));
            pg8::Gemm g{XKV, (const bf16_t*)(wl + W_UKV), MROWS, 512, kkv}; pg8::StaticOrder S; S.init(MROWS, 512, G, bx);
            pg8::EpiKV E{KC, VC};
            pg8::gemm_phase<pg8::EpiKV, pg8::StaticOrder, true, true>(lds, g, S, E);
        }
        GRID_BAR();
        {
            AttnArgs A{U, KC, VC, (bf16_t*)(ws + WS_O), a.in[3], a.in[9] + (size_t)l * 256, a.in[10] + (size_t)l * 128, a.in[11] + (size_t)l * 4, 0.8f - 0.6f * __expf(-0.3f * (float)l)};
            constexpr int NA = NSEQ * 4 * 65, NC = NSEQ * 2 * 65, NB = NSEQ * 2 * 65;
            unsigned* qhead = (unsigned*)ws + CW_QUEUE + 64 * l;
            for (;;) {
                if (threadIdx.x == 0) MISC[16] = atomicAdd(qhead, 1u);
                __syncthreads();
                const int u = (int)MISC[16];
                __syncthreads();
                if (u >= NA + NC + NB) break;
                if (l == 1 && (u % 65) == 0) continue;
                if (u < NA) ATTN_FN<0>(lds, u, A);
                else if (u < NA + NC) ATTN_FN<1>(lds, u - NA, A);
                else ATTN_FN<2>(lds, u - NA - NC, A);
            }
        }
        GRID_BAR();
        {
            pg8::Gemm g{(const bf16_t*)(ws + WS_O), (const bf16_t*)(wl + W_OUT), MROWS, 1024, 1024}; pg8::StaticOrder S; S.init(MROWS, 1024, G, bx);
            pg8::EpiResid E{LEAD, OUT, 1.0f, XN, a.in[17] + (size_t)l * DM, SSb + (size_t)((cons + 1) & 1) * MROWS, nullptr, nullptr};
            pg8::gemm_phase<pg8::EpiResid, pg8::StaticOrder, true, true>(lds, g, S, E);
        }
        ++cons;
        GRID_BAR();
    }
}

extern "C" void kernel_launch(void* const* d_in, const int* in_sizes, int n_in, void* d_out, int out_size, void* d_ws, size_t ws_size, hipStream_t stream) {
    static int grid = 0;
    if (grid == 0) {
        if (n_in != 21 || ws_size < WS_END) { fprintf(stderr, "kernel_launch: unexpected inputs (n_in %d, ws %zu, need %zu)\n", n_in, ws_size, (size_t)WS_END); grid = -1; return; }
        int dev = 0, cus = 0, per_cu = 0;
        hipGetDevice(&dev); hipDeviceGetAttribute(&cus, hipDeviceAttributeMultiprocessorCount, dev);
        if (hipFuncSetAttribute((const void*)mega_fwd, hipFuncAttributeMaxDynamicSharedMemorySize, LDS_BYTES) != hipSuccess) { fprintf(stderr, "kernel_launch: hipFuncSetAttribute failed\n"); grid = -1; return; }
        hipOccupancyMaxActiveBlocksPerMultiprocessor(&per_cu, (const void*)mega_fwd, NTHR, LDS_BYTES);
        (void)hipGetLastError();
        if (per_cu < 1) { fprintf(stderr, "kernel_launch: occupancy query says %d blocks per CU\n", per_cu); per_cu = 1; }
        grid = cus;
    }
    if (grid < 0) return;
    if (hipMemsetAsync(d_ws, 0, CTL_ZERO_BYTES, stream) != hipSuccess) { fprintf(stderr, "kernel_launch: memset failed\n"); return; }
    KArgs a{};
    for (int i = 0; i < 21; ++i) a.in[i] = (const float*)d_in[i];
    a.out = (float*)d_out; a.ws = (unsigned char*)d_ws;
    for (int j = 0; j < 16; ++j) a.inv[j] = (float)pow(10000.0, -(double)(2 * j) / 32.0);
    void* args[] = {&a};
    hipError_t e = hipLaunchCooperativeKernel((const void*)mega_fwd, dim3(grid), dim3(NTHR), args, LDS_BYTES, stream);
    if (e != hipSuccess) fprintf(stderr, "kernel_launch: cooperative launch failed: %s (grid %d)\n", hipGetErrorString(e), grid);
}
```
